# Optimizing an MI355X kernel written in HIP

```python
import math
import jax, jax.numpy as jnp
from jax import lax
import numpy as np

D_MODEL = 1024
BATCH = 8
SEQ = 8192
DEPTH = 2

N_MIXERS = 2
N_ATTN_LAYERS = (DEPTH + 1) // 2
N_GLA_LAYERS = DEPTH // 2

A_HEADS = 16
A_KV_HEADS = 4
A_HEAD_DIM = D_MODEL // A_HEADS
A_GROUP = A_HEADS // A_KV_HEADS
WINDOW = 128
A_BLOCK = 128
ROPE_THETA = 10000.0
A_IN_COLS = (A_HEADS + 2 * A_KV_HEADS) * A_HEAD_DIM

B_HEADS = 4
B_KEY_DIM = (D_MODEL // 2) // B_HEADS
B_VAL_DIM = D_MODEL // B_HEADS
B_GATE_RANK = 16
B_GATE_TAU = 16.0
B_CHUNK = 64
B_QK_COLS = B_HEADS * B_KEY_DIM
B_V_COLS = B_HEADS * B_VAL_DIM
B_IN_COLS = 2 * B_QK_COLS + 2 * B_V_COLS + 2 * B_GATE_RANK

D_FF = 4 * D_MODEL
DN_ALPHA = float((2 * DEPTH) ** 0.25)
DN_BETA = float((8 * DEPTH) ** -0.25)
LN_EPS = 1e-5
HEAD_NORM_EPS = 1e-6

kernel_name = 'hybrid_swa_gla_deepnorm_encoder'


def _layer_norm(x, g, b):
    xf = x.astype(jnp.float32)
    mu = jnp.mean(xf, axis=-1, keepdims=True)
    var = jnp.mean(jnp.square(xf - mu), axis=-1, keepdims=True)
    y = (xf - mu) * lax.rsqrt(var + LN_EPS)
    return (y * g.astype(jnp.float32) + b.astype(jnp.float32)).astype(x.dtype)


def _rope_tables(positions):
    inv_freq = ROPE_THETA ** (-jnp.arange(0, A_HEAD_DIM, 2, dtype=jnp.float32) / A_HEAD_DIM)
    ang = positions.astype(jnp.float32)[..., None] * inv_freq
    return jnp.cos(ang)[:, :, None, :], jnp.sin(ang)[:, :, None, :]


def _rope(t, cos, sin):
    tf = t.astype(jnp.float32)
    t1, t2 = jnp.split(tf, 2, axis=-1)
    return jnp.concatenate([t1 * cos - t2 * sin, t2 * cos + t1 * sin], axis=-1).astype(t.dtype)


def _window_gqa(x, w_in, sink, w_out, cos, sin):
    B, S, _ = x.shape
    hd = A_HEAD_DIM
    h = x @ w_in
    q, k, v = jnp.split(h, [A_HEADS * hd, (A_HEADS + A_KV_HEADS) * hd], axis=-1)
    q = _rope(q.reshape(B, S, A_HEADS, hd), cos, sin)
    k = _rope(k.reshape(B, S, A_KV_HEADS, hd), cos, sin)
    v = v.reshape(B, S, A_KV_HEADS, hd)
    nblk = S // A_BLOCK
    span = A_BLOCK + 2 * WINDOW
    pad = ((0, 0), (WINDOW, WINDOW), (0, 0), (0, 0))
    kp = jnp.pad(k, pad)
    vp = jnp.pad(v, pad)
    qb = q.reshape(B, nblk, A_BLOCK, A_KV_HEADS, A_GROUP, hd).transpose(1, 0, 2, 3, 4, 5)
    rel = jnp.arange(A_BLOCK)[:, None] + WINDOW - jnp.arange(span)[None, :]
    band = jnp.abs(rel) <= WINDOW
    sink_l = sink.astype(jnp.float32).reshape(1, A_KV_HEADS, A_GROUP, 1, 1)
    scale = hd ** -0.5

    def block(args):
        qi, i = args
        start = i * A_BLOCK
        ks = lax.dynamic_slice_in_dim(kp, start, span, axis=1)
        vs = lax.dynamic_slice_in_dim(vp, start, span, axis=1)
        kpos = start - WINDOW + jnp.arange(span)
        valid = band & ((kpos >= 0) & (kpos < S))[None, :]
        s = jnp.einsum('bqkgd,bskd->bkgqs', qi, ks, preferred_element_type=jnp.float32) * scale
        s = jnp.where(valid, s, -jnp.inf)
        sink_col = jnp.broadcast_to(sink_l, s.shape[:-1] + (1,))
        p = jax.nn.softmax(jnp.concatenate([s, sink_col], axis=-1), axis=-1)[..., :span]
        return jnp.einsum('bkgqs,bskd->bqkgd', p.astype(vs.dtype), vs)

    o = lax.map(block, (qb, jnp.arange(nblk)))
    o = o.transpose(1, 0, 2, 3, 4, 5).reshape(B, S, A_HEADS * hd)
    return o @ w_out


def _gla_chunked(q, k, v, g):
    B, S, H, dk = q.shape
    dv = v.shape[-1]
    n = S // B_CHUNK

    def to_chunks(t):
        return t.reshape((B, n, B_CHUNK) + t.shape[2:]).swapaxes(0, 1)

    tril = jnp.tril(jnp.ones((B_CHUNK, B_CHUNK), dtype=bool))

    def step(state, inp):
        qc, kc, vc, gc = inp
        b = jnp.cumsum(gc, axis=1)
        qf = qc.astype(jnp.float32)
        kf = kc.astype(jnp.float32)
        vf = vc.astype(jnp.float32)
        qe = qf * jnp.exp(b)
        ke = kf * jnp.exp(-b)
        att = jnp.where(tril, jnp.einsum('bthd,bshd->bhts', qe, ke), 0.0)
        o = jnp.einsum('bhts,bshv->bthv', att, vf) + jnp.einsum('bthd,bhdv->bthv', qe, state)
        b_last = b[:, -1]
        kd = kf * jnp.exp(b_last[:, None] - b)
        state = jnp.exp(b_last)[..., None] * state + jnp.einsum('bshd,bshv->bhdv', kd, vf)
        return state, o.astype(vc.dtype)

    s0 = jnp.zeros((B, H, dk, dv), jnp.float32)
    _, o = lax.scan(step, s0, (to_chunks(q), to_chunks(k), to_chunks(v), to_chunks(g)))
    return o.swapaxes(0, 1).reshape(B, S, H, dv)


def _bidir_gla(x, w_in, gw2_f, gb_f, gw2_b, gb_b, norm_g, w_out):
    B, S, _ = x.shape
    h = x @ w_in
    c1 = B_QK_COLS
    c2 = 2 * B_QK_COLS
    c3 = c2 + B_V_COLS
    c4 = c3 + B_V_COLS
    c5 = c4 + B_GATE_RANK
    q, k, v, r, lr_f, lr_b = jnp.split(h, [c1, c2, c3, c4, c5], axis=-1)
    q = q.reshape(B, S, B_HEADS, B_KEY_DIM) * (B_KEY_DIM ** -0.5)
    k = k.reshape(B, S, B_HEADS, B_KEY_DIM)
    v = v.reshape(B, S, B_HEADS, B_VAL_DIM)

    def log_gate(lr, w2, bias):
        z = (lr @ w2 + bias).astype(jnp.float32)
        return (jax.nn.log_sigmoid(z) / B_GATE_TAU).reshape(B, S, B_HEADS, B_KEY_DIM)

    g_f = log_gate(lr_f, gw2_f, gb_f)
    g_b = log_gate(lr_b, gw2_b, gb_b)
    o_f = _gla_chunked(q, k, v, g_f)
    flip = lambda t: jnp.flip(t, axis=1)
    o_b = flip(_gla_chunked(flip(q), flip(k), flip(v), flip(g_b)))
    of = o_f.astype(jnp.float32) + o_b.astype(jnp.float32)
    of = of * lax.rsqrt(jnp.mean(jnp.square(of), axis=-1, keepdims=True) + HEAD_NORM_EPS)
    of = of * norm_g.astype(jnp.float32)
    o = of.astype(x.dtype).reshape(B, S, B_V_COLS) * jax.nn.silu(r)
    return o @ w_out


def _sqrelu_mlp(x, w1, w2):
    return jnp.square(jax.nn.relu(x @ w1)) @ w2


def setup_inputs(seed: int = 0) -> dict:
    key = jax.random.key(seed)
    ks = jax.random.split(key, 20)
    f32 = jnp.float32
    nrm = lambda kk, shape, s: jax.random.normal(kk, shape, f32) * s
    x = jax.random.normal(ks[0], (BATCH, SEQ, D_MODEL), f32)
    offs = jax.random.randint(ks[1], (BATCH, 1), 0, 4096, dtype=jnp.int32)
    positions = (jnp.arange(SEQ, dtype=jnp.int32)[None, :] + offs).astype(jnp.int32)
    d_inv = D_MODEL ** -0.5
    return {
        'x': x,
        'positions': positions,
        'attn_w_in': nrm(ks[2], (N_ATTN_LAYERS, D_MODEL, A_IN_COLS), d_inv),
        'attn_sink': nrm(ks[3], (N_ATTN_LAYERS, A_HEADS), 0.5),
        'attn_w_out': nrm(ks[4], (N_ATTN_LAYERS, A_HEADS * A_HEAD_DIM, D_MODEL), d_inv * DN_BETA),
        'gla_w_in': nrm(ks[5], (N_GLA_LAYERS, D_MODEL, B_IN_COLS), d_inv),
        'gla_gate_w2_fwd': nrm(ks[6], (N_GLA_LAYERS, B_GATE_RANK, B_QK_COLS), B_GATE_RANK ** -0.5),
        'gla_gate_b_fwd': nrm(ks[7], (N_GLA_LAYERS, B_QK_COLS), 0.02),
        'gla_gate_w2_bwd': nrm(ks[8], (N_GLA_LAYERS, B_GATE_RANK, B_QK_COLS), B_GATE_RANK ** -0.5),
        'gla_gate_b_bwd': nrm(ks[9], (N_GLA_LAYERS, B_QK_COLS), 0.02),
        'gla_norm_g': 1.0 + nrm(ks[10], (N_GLA_LAYERS, B_VAL_DIM), 0.02),
        'gla_w_out': nrm(ks[11], (N_GLA_LAYERS, B_V_COLS, D_MODEL), (B_V_COLS ** -0.5) * DN_BETA),
        'mix_ln_g': 1.0 + nrm(ks[12], (DEPTH, D_MODEL), 0.02),
        'mix_ln_b': nrm(ks[13], (DEPTH, D_MODEL), 0.02),
        'mlp_w1': nrm(ks[14], (DEPTH, D_MODEL, D_FF), d_inv),
        'mlp_w2': nrm(ks[15], (DEPTH, D_FF, D_MODEL), (D_FF ** -0.5) * DN_BETA),
        'mlp_ln_g': 1.0 + nrm(ks[16], (DEPTH, D_MODEL), 0.02),
        'mlp_ln_b': nrm(ks[17], (DEPTH, D_MODEL), 0.02),
    }


def reference(x, positions, attn_w_in, attn_sink, attn_w_out, gla_w_in, gla_gate_w2_fwd,
              gla_gate_b_fwd, gla_gate_w2_bwd, gla_gate_b_bwd, gla_norm_g, gla_w_out,
              mix_ln_g, mix_ln_b, mlp_w1, mlp_w2, mlp_ln_g, mlp_ln_b):
    cos, sin = _rope_tables(positions)
    for i in range(DEPTH):
        j = i // N_MIXERS
        if i % N_MIXERS == 0:
            y = _window_gqa(x, attn_w_in[j], attn_sink[j], attn_w_out[j], cos, sin)
        else:
            y = _bidir_gla(x, gla_w_in[j], gla_gate_w2_fwd[j], gla_gate_b_fwd[j],
                           gla_gate_w2_bwd[j], gla_gate_b_bwd[j], gla_norm_g[j], gla_w_out[j])
        x = _layer_norm(DN_ALPHA * x + y, mix_ln_g[i], mix_ln_b[i])
        x = _layer_norm(DN_ALPHA * x + _sqrelu_mlp(x, mlp_w1[i], mlp_w2[i]), mlp_ln_g[i], mlp_ln_b[i])
    return x
```

```cpp
#include <hip/hip_runtime.h>
#include <hip/hip_cooperative_groups.h>
#include <cstdio>
#include <cstdint>
#include <cmath>
namespace cg = cooperative_groups;
namespace pg8 {
#define PG8_LAS __attribute__((address_space(3)))
typedef unsigned short bf16_t;
typedef short bf16x8 __attribute__((ext_vector_type(8)));
typedef float f32x4 __attribute__((ext_vector_type(4)));
typedef unsigned u32x4 __attribute__((ext_vector_type(4)));
constexpr int BM = 256, BK = 64, HALF = 128, HTB = HALF * BK * 2  , STAGE_BYTES = 8 * HTB, NXCD = 8, WGM = 8;

__host__ __device__ __forceinline__ int lds_byte(int r, int c) { const int st = (r >> 4) * 2 + (c >> 5), rr = r & 15, cc = c & 31, ob = rr * 64 + cc * 2; return st * 1024 + (ob ^ (((ob >> 9) & 1) << 5)); }
__host__ __device__ __forceinline__ void stage_rc(int b, int& R, int& C) { const int st = b / 1024, sb = b % 1024, swz = sb ^ (((sb >> 9) & 1) << 5); R = (st >> 1) * 16 + swz / 64; C = (st & 1) * 32 + (swz % 64) / 2; }
__host__ __device__ __forceinline__ int perm32(int rho) { const int n = rho >> 4, i = rho & 15; return 8 * (i >> 2) + 4 * n + (i & 3); }

struct Unit { int pm, pn; };
struct Gemm { const bf16_t* A; const bf16_t* Bt; int M, N, K; };

struct StaticOrder {
    int nM, nN, nwg, G, c;
    __host__ __device__ void init(int M, int N, int G_, int c_) { nM = M / BM; nN = N / BM; nwg = nM * nN; G = G_; c = c_; }
    __host__ __device__ bool next(int i, Unit& u) const {
        const long L = (long)i * G + c; if (L >= nwg) return false;
        int wgid = (int)L; { const int q = nwg / NXCD, r = nwg % NXCD, xcd = wgid % NXCD, off = wgid / NXCD; wgid = (xcd < r ? xcd * (q + 1) : r * (q + 1) + (xcd - r) * q) + off; }
        const int nig = WGM * nN, gid = wgid / nig, fm = gid * WGM, gsz = (nM - fm) < WGM ? (nM - fm) : WGM;
        u.pm = fm + ((wgid % nig) % gsz); u.pn = (wgid % nig) / gsz; return true;
    }
    __device__ __forceinline__ void a_ready(const Unit&) const {}
    __device__ __forceinline__ void done(const Unit&) const {}
};

__device__ __forceinline__ unsigned cvt_pk_bf16(float lo, float hi) { unsigned r; asm volatile("v_cvt_pk_bf16_f32 %0, %1, %2" : "=v"(r) : "v"(lo), "v"(hi)); return r; }
typedef float f32x2 __attribute__((ext_vector_type(2)));
typedef unsigned u32x2 __attribute__((ext_vector_type(2)));
__device__ __forceinline__ u32x4 pack8(f32x4 a, f32x4 b) { u32x4 w; w.x = cvt_pk_bf16(a[0], a[1]); w.y = cvt_pk_bf16(a[2], a[3]); w.z = cvt_pk_bf16(b[0], b[1]); w.w = cvt_pk_bf16(b[2], b[3]); return w; }

struct EpiQKV {
    static constexpr bool PERM = true, AFTER_DRAIN = false;
    bf16_t* Q; bf16_t* Kb; bf16_t* Vb; const float* cosT; const float* sinT; float qscale;
    __device__ __forceinline__ void operator()(const f32x4 (&acc)[2][2][4][2], const Unit& u, int wr, int wc, int fr, int fq) const {
        const int row0 = u.pm * BM + wr * 64 + fr; const int pn = u.pn;
        if (pn == 5) {
            const int col0 = wc * 32 + 8 * fq;
#pragma unroll
            for (int ai = 0; ai < 2; ++ai)
#pragma unroll
                for (int m = 0; m < 4; ++m) { bf16_t* rowp = Vb + (size_t)(row0 + ai * HALF + m * 16) * 256 + col0;
#pragma unroll
                    for (int bj = 0; bj < 2; ++bj) *(u32x4*)(rowp + bj * HALF) = pack8(acc[ai][bj][m][0], acc[ai][bj][m][1]); }
        } else {
            bf16_t* base; int ld, colt; float sc;
            if (pn < 4) { base = Q; ld = 1024; colt = pn * 256; sc = qscale; } else { base = Kb; ld = 256; colt = 0; sc = 1.f; }
            const int col0 = colt + wc * 32 + 8 * fq; const int d1 = 16 * (wc & 1) + 4 * fq;
            f32x4 cs[2][2], sn[2][2];
#define QKV_LOAD(bt, bf) do { _Pragma("unroll") for (int i_ = 0; i_ < 2; ++i_) { const int r8_ = 2 * (bt) + i_; const int row_ = row0 + (r8_ >> 2) * HALF + (r8_ & 3) * 16; \
                cs[bf][i_] = *(const f32x4*)(cosT + (size_t)row_ * 32 + d1); sn[bf][i_] = *(const f32x4*)(sinT + (size_t)row_ * 32 + d1); } } while (0)
            QKV_LOAD(0, 0);
#pragma unroll
            for (int bt = 0; bt < 4; ++bt) {
                if (bt + 1 < 4) { if ((bt + 1) & 1) QKV_LOAD(bt + 1, 1); else QKV_LOAD(bt + 1, 0); }
#pragma unroll
                for (int i = 0; i < 2; ++i) { const int r8 = 2 * bt + i, ai = r8 >> 2, m = r8 & 3; const int row = row0 + ai * HALF + m * 16;
                    const f32x4 c4 = cs[bt & 1][i], s4 = sn[bt & 1][i];
#pragma unroll
                    for (int bj = 0; bj < 2; ++bj) { const f32x4 t1 = acc[ai][bj][m][0], t2 = acc[ai][bj][m][1];
                        const f32x4 o1 = (t1 * c4 - t2 * s4) * sc, o2 = (t2 * c4 + t1 * s4) * sc;
                        *(u32x4*)(base + (size_t)row * ld + col0 + bj * HALF) = pack8(o1, o2); } }
            }
#undef QKV_LOAD
        }
    }
};
template <int MODE> struct EpiRes {
    static constexpr bool PERM = true, AFTER_DRAIN = false;
    const float* Rf; const bf16_t* Rb; const float* stats; const float* g; const float* b; bf16_t* ZB; float* STout;
    static constexpr float alpha = 1.41421356237309515f;
    __device__ __forceinline__ void operator()(const f32x4 (&acc)[2][2][4][2], const Unit& u, int wr, int wc, int fr, int fq) const {
        const int row0 = u.pm * BM + wr * 64 + fr, col0 = u.pn * BM + wc * 32 + 8 * fq;
        f32x4 rf[2][2][2]; u32x4 rbb[2][2]; f32x2 sb[2];
#define RES_LOAD(r8_, bf) do { const int row_ = row0 + ((r8_) >> 2) * HALF + ((r8_) & 3) * 16; const size_t off_ = (size_t)row_ * 1024 + col0; \
            if constexpr (MODE >= 1) { if constexpr (MODE == 1) sb[bf] = *(const f32x2*)(stats + 2 * (size_t)row_); rbb[bf][0] = *(const u32x4*)(Rb + off_); rbb[bf][1] = *(const u32x4*)(Rb + off_ + HALF); } \
            else { rf[bf][0][0] = *(const f32x4*)(Rf + off_); rf[bf][0][1] = *(const f32x4*)(Rf + off_ + 4); rf[bf][1][0] = *(const f32x4*)(Rf + off_ + HALF); rf[bf][1][1] = *(const f32x4*)(Rf + off_ + HALF + 4); } } while (0)
        RES_LOAD(0, 0);
        f32x4 gg[2][2], bb[2][2];
        if constexpr (MODE == 1) {
#pragma unroll
            for (int bj = 0; bj < 2; ++bj)
#pragma unroll
                for (int n = 0; n < 2; ++n) { gg[bj][n] = *(const f32x4*)(g + col0 + bj * HALF + 4 * n); bb[bj][n] = *(const f32x4*)(b + col0 + bj * HALF + 4 * n); }
        }
#pragma unroll
        for (int r8 = 0; r8 < 8; ++r8) {
            if (r8 + 1 < 8) RES_LOAD(r8 + 1, (r8 + 1) & 1);
            const int ai = r8 >> 2, m = r8 & 3; const int row = row0 + ai * HALF + m * 16; const size_t off = (size_t)row * 1024 + col0;
            float mean = 0.f, rstd = 1.f; if constexpr (MODE == 1) { const f32x2 st = sb[r8 & 1]; mean = st.x * (1.f / 1024.f); rstd = __builtin_amdgcn_rsqf(st.y * (1.f / 1024.f) - mean * mean + 1e-5f); }
            float s = 0.f, ss = 0.f;
#pragma unroll
            for (int bj = 0; bj < 2; ++bj) { f32x4 r0, r1;
                if constexpr (MODE >= 1) { const u32x4 w = rbb[r8 & 1][bj];
                    r0 = (f32x4){__builtin_bit_cast(float, w.x << 16), __builtin_bit_cast(float, w.x & 0xffff0000u), __builtin_bit_cast(float, w.y << 16), __builtin_bit_cast(float, w.y & 0xffff0000u)};
                    r1 = (f32x4){__builtin_bit_cast(float, w.z << 16), __builtin_bit_cast(float, w.z & 0xffff0000u), __builtin_bit_cast(float, w.w << 16), __builtin_bit_cast(float, w.w & 0xffff0000u)};
                    if constexpr (MODE == 1) { r0 = (r0 - mean) * rstd * gg[bj][0] + bb[bj][0]; r1 = (r1 - mean) * rstd * gg[bj][1] + bb[bj][1]; } }
                else { r0 = rf[r8 & 1][bj][0]; r1 = rf[r8 & 1][bj][1]; }
                const f32x4 o0 = r0 * alpha + acc[ai][bj][m][0], o1 = r1 * alpha + acc[ai][bj][m][1];
                *(u32x4*)(ZB + off + bj * HALF) = pack8(o0, o1);
                s += ((o0[0] + o0[1]) + (o0[2] + o0[3])) + ((o1[0] + o1[1]) + (o1[2] + o1[3]));
                ss += ((o0[0] * o0[0] + o0[1] * o0[1]) + (o0[2] * o0[2] + o0[3] * o0[3])) + ((o1[0] * o1[0] + o1[1] * o1[1]) + (o1[2] * o1[2] + o1[3] * o1[3])); }
            if (STout) { s += __shfl_xor(s, 16); s += __shfl_xor(s, 32); ss += __shfl_xor(ss, 16); ss += __shfl_xor(ss, 32);
                if (fq == 0) { __hip_atomic_fetch_add(STout + 2 * (size_t)row, s, __ATOMIC_RELAXED, __HIP_MEMORY_SCOPE_AGENT); __hip_atomic_fetch_add(STout + 2 * (size_t)row + 1, ss, __ATOMIC_RELAXED, __HIP_MEMORY_SCOPE_AGENT); } }
        }
#undef RES_LOAD
    }
};
struct LnFold { const float* st; const float* cs; const float* cb; };
__device__ __forceinline__ void ln_rows8(const float* st, int row0, float (&mean)[8], float (&rstd)[8]) {
    f32x2 v[8];
#pragma unroll
    for (int r8 = 0; r8 < 8; ++r8) v[r8] = *(const f32x2*)(st + 2 * (size_t)(row0 + (r8 >> 2) * HALF + (r8 & 3) * 16));
#pragma unroll
    for (int r8 = 0; r8 < 8; ++r8) { mean[r8] = v[r8].x * (1.f / 1024.f); rstd[r8] = __builtin_amdgcn_rsqf(v[r8].y * (1.f / 1024.f) - mean[r8] * mean[r8] + 1e-5f); }
}
struct EpiSqRelu {
    static constexpr bool PERM = true, AFTER_DRAIN = false;
    bf16_t* O; int ldc; LnFold f;
    __device__ __forceinline__ void operator()(const f32x4 (&acc)[2][2][4][2], const Unit& u, int wr, int wc, int fr, int fq) const {
        const int row0 = u.pm * BM + wr * 64, col0 = u.pn * BM + wc * 32 + 8 * fq; const f32x4 zero = {0.f, 0.f, 0.f, 0.f};
        f32x4 cs[2][2], cb[2][2];
#pragma unroll
        for (int bj = 0; bj < 2; ++bj)
#pragma unroll
            for (int n = 0; n < 2; ++n) { cs[bj][n] = *(const f32x4*)(f.cs + col0 + bj * HALF + 4 * n); cb[bj][n] = *(const f32x4*)(f.cb + col0 + bj * HALF + 4 * n); }
        float mean8[8], rstd8[8]; ln_rows8(f.st, row0 + fr, mean8, rstd8);
        const int hb = fr >> 3, r7 = fr & 7; const int pcol = u.pn * BM + 64 * wc + 32 * hb + 8 * fq;
#pragma unroll
        for (int ai = 0; ai < 2; ++ai)
#pragma unroll
            for (int m = 0; m < 4; ++m) { const float mean = mean8[ai * 4 + m], rstd = rstd8[ai * 4 + m];
                u32x4 d[2];
#pragma unroll
                for (int bj = 0; bj < 2; ++bj) {
                    f32x4 v0 = (acc[ai][bj][m][0] - cs[bj][0] * mean) * rstd + cb[bj][0], v1 = (acc[ai][bj][m][1] - cs[bj][1] * mean) * rstd + cb[bj][1];
                    v0 = __builtin_elementwise_max(v0, zero); v1 = __builtin_elementwise_max(v1, zero); d[bj] = pack8(v0 * v0, v1 * v1); }
                const u32x4 snd = hb ? d[0] : d[1]; u32x4 rcv;
                rcv.x = __shfl_xor(snd.x, 8); rcv.y = __shfl_xor(snd.y, 8); rcv.z = __shfl_xor(snd.z, 8); rcv.w = __shfl_xor(snd.w, 8);
                const int rbase = row0 + ai * HALF + m * 16;
                __builtin_nontemporal_store(hb ? rcv : d[0], (u32x4*)(O + (size_t)(rbase + r7) * ldc + pcol));
                __builtin_nontemporal_store(hb ? d[1] : rcv, (u32x4*)(O + (size_t)(rbase + 8 + r7) * ldc + pcol)); }
    }
};
struct EpiGin {
    static constexpr bool PERM = true, AFTER_DRAIN = false;
    bf16_t* Gq; bf16_t* Gk; bf16_t* Gv; bf16_t* Gr; float* LR; float qscale; LnFold f;
    __device__ __forceinline__ void operator()(const f32x4 (&acc)[2][2][4][2], const Unit& u, int wr, int wc, int fr, int fq) const {
        const int row0 = u.pm * BM + wr * 64 + fr; const int pn = u.pn; const int ccol0 = pn * BM + wc * 32 + 8 * fq;
        f32x4 cs[2][2], cb[2][2];
#pragma unroll
        for (int bj = 0; bj < 2; ++bj)
#pragma unroll
            for (int n = 0; n < 2; ++n) { cs[bj][n] = *(const f32x4*)(f.cs + ccol0 + bj * HALF + 4 * n); cb[bj][n] = *(const f32x4*)(f.cb + ccol0 + bj * HALF + 4 * n); }
        float mean8[8], rstd8[8]; ln_rows8(f.st, row0, mean8, rstd8);
        bf16_t* base; int ld, colt; float sc = 1.f;
        if (pn < 2) { base = Gq; ld = 512; colt = pn * 256; sc = qscale; } else if (pn < 4) { base = Gk; ld = 512; colt = (pn - 2) * 256; }
        else if (pn < 8) { base = Gv; ld = 1024; colt = (pn - 4) * 256; } else { base = Gr; ld = 1024; colt = (pn - 8) * 256; }
        const int col0 = colt + wc * 32 + 8 * fq;
#pragma unroll
        for (int ai = 0; ai < 2; ++ai)
#pragma unroll
            for (int m = 0; m < 4; ++m) { const int row = row0 + ai * HALF + m * 16; const float mean = mean8[ai * 4 + m], rstd = rstd8[ai * 4 + m];
#pragma unroll
                for (int bj = 0; bj < 2; ++bj) {
                    const f32x4 v0 = ((acc[ai][bj][m][0] - cs[bj][0] * mean) * rstd + cb[bj][0]) * sc, v1 = ((acc[ai][bj][m][1] - cs[bj][1] * mean) * rstd + cb[bj][1]) * sc;
                    if (pn == 12) { if (bj == 0 && wc == 0) { float* p = LR + (size_t)row * 32 + 8 * fq; *(f32x4*)p = v0; *(f32x4*)(p + 4) = v1; } }
                    else *(u32x4*)(base + (size_t)row * ld + col0 + bj * HALF) = pack8(v0, v1); } }
    }
};

template <class Epi, class Sched, bool ALIGN_EPI = false, bool SP2 = false>
__device__ __forceinline__ void gemm_phase(PG8_LAS unsigned char* lds, const Gemm g, const Sched& S, const Epi& E) {
    const int tid = threadIdx.x, wid = __builtin_amdgcn_readfirstlane(tid >> 6), lane = tid & 63, wr = wid >> 2, wc = wid & 3, fr = lane & 15, fq = lane >> 4;
    const int K = g.K, nt = K / BK;
    unsigned voffA[2], voffB[2];
#pragma unroll
    for (int i = 0; i < 2; ++i) { int R, C; stage_rc(tid * 16 + i * 8192, R, C); const int Rb = Epi::PERM ? ((R & ~31) + perm32(R & 31)) : R;
        voffA[i] = (unsigned)(R * K + C) * 2u; voffB[i] = (unsigned)(Rb * K + C) * 2u; }
    const size_t kstep = (size_t)(BK * 2);
    const size_t hstep = (size_t)HALF * K * 2;
    const size_t tstep = 2 * hstep;
    const unsigned ldsw = (unsigned)wid * 1024u;
    const int aoff = lds_byte(wr * 64 + fr, fq * 8), boff = lds_byte(wc * 32 + fr, fq * 8);
#define PG8_SA(b, h) (((b) * 2 + (h)) * HTB)
#define PG8_SB(b, h) ((4 + (b) * 2 + (h)) * HTB)
#define PG8_STAGE(bufoff, gbase, voff) do { _Pragma("unroll") for (int _i = 0; _i < 2; ++_i) \
        __builtin_amdgcn_global_load_lds((const unsigned*)((const char*)(gbase) + (voff)[_i]), (PG8_LAS unsigned*)(lds + (bufoff) + ldsw + _i * 8192), 16, 0, 0); } while (0)
#define PG8_LDA(dst, b, h) do { _Pragma("unroll") for (int m = 0; m < 4; ++m) _Pragma("unroll") for (int k = 0; k < 2; ++k) dst[m][k] = *(const PG8_LAS bf16x8*)(lds + PG8_SA(b, h) + aoff + m * 2048 + k * 1024); } while (0)
#define PG8_LDB(dst, b, h) do { _Pragma("unroll") for (int n = 0; n < 2; ++n) _Pragma("unroll") for (int k = 0; k < 2; ++k) dst[n][k] = *(const PG8_LAS bf16x8*)(lds + PG8_SB(b, h) + boff + n * 2048 + k * 1024); } while (0)
#define PG8_MMA(ai, bj, At, Bt) do { __builtin_amdgcn_s_setprio(1); _Pragma("unroll") for (int m = 0; m < 4; ++m) _Pragma("unroll") for (int n = 0; n < 2; ++n) _Pragma("unroll") for (int k = 0; k < 2; ++k) \
        acc[ai][bj][m][n] = __builtin_amdgcn_mfma_f32_16x16x32_bf16(Bt[n][k], At[m][k], acc[ai][bj][m][n], 0, 0, 0); __builtin_amdgcn_s_setprio(0); } while (0)
#define PG8_WAIT_V(n) asm volatile("s_waitcnt vmcnt(" #n ")" ::: "memory")
#define PG8_WAIT_L(n) asm volatile("s_waitcnt lgkmcnt(" #n ")" ::: "memory")
#define PG8_BAR __builtin_amdgcn_s_barrier()
#define PG8_SCHED __builtin_amdgcn_sched_barrier(0)
    Unit cur, nxt; int ui = 0;
    if (!S.next(0, cur)) return;
    f32x4 acc[2][2][4][2];
#pragma unroll
    for (int a = 0; a < 2; ++a)
#pragma unroll
        for (int b = 0; b < 2; ++b)
#pragma unroll
            for (int m = 0; m < 4; ++m)
#pragma unroll
                for (int n = 0; n < 2; ++n) acc[a][b][m][n] = (f32x4){0.f, 0.f, 0.f, 0.f};
    bf16x8 At[4][2], B0[2][2], B1[2][2];
    const char* cA = (const char*)g.A + (size_t)cur.pm * tstep; const char* cB = (const char*)g.Bt + (size_t)cur.pn * tstep;
    S.a_ready(cur);
    if constexpr (SP2) {
        PG8_STAGE(PG8_SB(0, 0), cB, voffB); PG8_STAGE(PG8_SB(0, 1), cB + hstep, voffB); PG8_STAGE(PG8_SA(0, 0), cA, voffA); PG8_STAGE(PG8_SA(0, 1), cA + hstep, voffA);
        if (wr == 1) PG8_BAR;
        PG8_WAIT_V(2); PG8_BAR;
        PG8_STAGE(PG8_SB(1, 0), cB + kstep, voffB); PG8_STAGE(PG8_SA(1, 0), cA + kstep, voffA); PG8_STAGE(PG8_SB(1, 1), cB + hstep + kstep, voffB);
        PG8_WAIT_V(6); PG8_BAR;
    } else {
        PG8_STAGE(PG8_SB(0, 0), cB, voffB); PG8_STAGE(PG8_SA(0, 0), cA, voffA); PG8_STAGE(PG8_SB(0, 1), cB + hstep, voffB); PG8_STAGE(PG8_SA(0, 1), cA + hstep, voffA);
        if (wr == 1) PG8_BAR;
        PG8_WAIT_V(4); PG8_BAR;
        PG8_STAGE(PG8_SB(1, 0), cB + kstep, voffB); PG8_STAGE(PG8_SA(1, 0), cA + kstep, voffA); PG8_STAGE(PG8_SB(1, 1), cB + hstep + kstep, voffB);
        PG8_WAIT_V(6); PG8_BAR;
    }
    for (;;) {
        const bool has_next = S.next(ui + 1, nxt);
        const char* nA = has_next ? (const char*)g.A + (size_t)nxt.pm * tstep : cA; const char* nB = has_next ? (const char*)g.Bt + (size_t)nxt.pn * tstep : cB;
        for (int t = 0; t < nt; t += 2) {
            const bool last = (t == nt - 2);
            const char* a1 = cA + (size_t)(t + 1) * kstep;
            const char* a2 = last ? nA : cA + (size_t)(t + 2) * kstep; const char* b2 = last ? nB : cB + (size_t)(t + 2) * kstep;
            const char* a3 = a2 + kstep; const char* b3 = b2 + kstep;
            if (last && has_next) S.a_ready(nxt);
            if constexpr (SP2) {
            PG8_LDB(B0, 0, 0); PG8_LDB(B1, 0, 1); PG8_SCHED; PG8_LDA(At, 0, 0); PG8_STAGE(PG8_SA(1, 1), a1 + hstep, voffA);
            PG8_WAIT_V(8); PG8_WAIT_L(0); PG8_BAR; PG8_MMA(0, 0, At, B0); PG8_MMA(0, 1, At, B1); PG8_BAR; PG8_SCHED;
            PG8_LDA(At, 0, 1); PG8_STAGE(PG8_SB(0, 0), b2, voffB); PG8_STAGE(PG8_SB(0, 1), b2 + hstep, voffB); PG8_STAGE(PG8_SA(0, 0), a2, voffA);
            PG8_WAIT_V(8); PG8_WAIT_L(0); PG8_BAR; PG8_MMA(1, 0, At, B0); PG8_MMA(1, 1, At, B1); PG8_BAR; PG8_SCHED;
            PG8_LDB(B0, 1, 0); PG8_LDB(B1, 1, 1); PG8_SCHED; PG8_LDA(At, 1, 0); PG8_STAGE(PG8_SA(0, 1), a2 + hstep, voffA);
            PG8_WAIT_V(8); PG8_WAIT_L(0); PG8_BAR; PG8_MMA(0, 0, At, B0); PG8_MMA(0, 1, At, B1); PG8_BAR; PG8_SCHED;
            PG8_LDA(At, 1, 1); PG8_STAGE(PG8_SB(1, 0), b3, voffB); PG8_STAGE(PG8_SB(1, 1), b3 + hstep, voffB); PG8_STAGE(PG8_SA(1, 0), a3, voffA);
            PG8_WAIT_V(8); PG8_WAIT_L(0); PG8_BAR; PG8_MMA(1, 0, At, B0); PG8_MMA(1, 1, At, B1); PG8_BAR; PG8_SCHED;
            } else {
            PG8_LDB(B0, 0, 0); PG8_SCHED; PG8_LDA(At, 0, 0); PG8_STAGE(PG8_SA(1, 1), a1 + hstep, voffA);
            PG8_WAIT_L(8); PG8_BAR; PG8_WAIT_L(0); PG8_MMA(0, 0, At, B0); PG8_BAR; PG8_SCHED;
            PG8_LDB(B1, 0, 1); PG8_STAGE(PG8_SB(0, 0), b2, voffB);
            PG8_BAR; PG8_WAIT_L(0); PG8_MMA(0, 1, At, B1); PG8_BAR;
            PG8_LDA(At, 0, 1); PG8_STAGE(PG8_SA(0, 0), a2, voffA);
            PG8_BAR; PG8_WAIT_L(0); PG8_MMA(1, 0, At, B0); PG8_BAR; PG8_SCHED;
            PG8_STAGE(PG8_SB(0, 1), b2 + hstep, voffB);
            PG8_WAIT_V(6); PG8_BAR; PG8_MMA(1, 1, At, B1); PG8_BAR;
            PG8_LDB(B0, 1, 0); PG8_SCHED; PG8_LDA(At, 1, 0); PG8_STAGE(PG8_SA(0, 1), a2 + hstep, voffA);
            PG8_WAIT_L(8); PG8_BAR; PG8_WAIT_L(0); PG8_MMA(0, 0, At, B0); PG8_BAR; PG8_SCHED;
            PG8_LDB(B1, 1, 1); PG8_STAGE(PG8_SB(1, 0), b3, voffB);
            PG8_BAR; PG8_WAIT_L(0); PG8_MMA(0, 1, At, B1); PG8_BAR;
            PG8_LDA(At, 1, 1); PG8_STAGE(PG8_SA(1, 0), a3, voffA);
            PG8_BAR; PG8_WAIT_L(0); PG8_MMA(1, 0, At, B0); PG8_BAR; PG8_SCHED;
            PG8_STAGE(PG8_SB(1, 1), b3 + hstep, voffB);
            PG8_WAIT_V(6); PG8_BAR; PG8_MMA(1, 1, At, B1); PG8_BAR;
            }
        }
        if constexpr (ALIGN_EPI) { if (wr == 0) PG8_BAR; }
        if constexpr (!Epi::AFTER_DRAIN) { E(acc, cur, wr, wc, fr, fq); S.done(cur); }
        if (!has_next) break;
#pragma unroll
        for (int a = 0; a < 2; ++a)
#pragma unroll
            for (int b = 0; b < 2; ++b)
#pragma unroll
                for (int m = 0; m < 4; ++m)
#pragma unroll
                    for (int n = 0; n < 2; ++n) acc[a][b][m][n] = (f32x4){0.f, 0.f, 0.f, 0.f};
        cur = nxt; cA = nA; cB = nB; ++ui;
        if constexpr (ALIGN_EPI) { if (wr == 1) PG8_BAR; }
    }
    PG8_WAIT_V(0);
    if constexpr (!ALIGN_EPI) { if (wr == 0) PG8_BAR; }
    PG8_BAR;
    if constexpr (Epi::AFTER_DRAIN) { E.fused(acc, cur, wr, wc, fr, fq, lds, wid, lane); S.done(cur); }
#undef PG8_SA
#undef PG8_SB
#undef PG8_STAGE
#undef PG8_LDA
#undef PG8_LDB
#undef PG8_MMA
#undef PG8_WAIT_V
#undef PG8_WAIT_L
#undef PG8_BAR
#undef PG8_SCHED
}
}

#ifndef PG8_SP2
#define PG8_SP2 true
#endif
#ifndef PG8_ALIGN
#define PG8_ALIGN true
#endif
constexpr int NB = 8, SEQ = 8192, DM = 1024, FF = 4096, M = NB * SEQ;
constexpr int AH = 16, AKV = 4, AHD = 64, A_IN = 1536;
constexpr int GH = 4, GDK = 128, GDV = 256, G_IN = 3104, G_INP = 3328, GQK = 512, GVC = 1024;
constexpr float LN_EPS = 1e-5f, HN_EPS = 1e-6f;
constexpr float DN_ALPHA = 1.41421356237309515f;
constexpr float LOG2E = 1.4426950408889634f;
constexpr int NWAVES = 8, NTHREADS = 512;
constexpr size_t MiB = 1u << 20;
constexpr size_t WS_CTL = 0, CTL_ZERO_BYTES = 2 * MiB;
constexpr size_t WS_FOLD = 32 * 1024;
constexpr size_t WS_ST4 = 13 * MiB + 512 * 1024;
constexpr size_t WS_ST1 = 512 * 1024, WS_ST2 = 1024 * 1024, WS_ST3 = 1536 * 1024;
constexpr size_t WS_WAIN = 2 * MiB, WS_WAOUT = 5 * MiB, WS_WGIN = 7 * MiB, WS_WGOUT = 14 * MiB, WS_W1 = 16 * MiB, WS_W2 = 32 * MiB;
constexpr size_t WS_COS = 48 * MiB, WS_SIN = 56 * MiB;
constexpr size_t WS_LR = 48 * MiB, WS_DL = 56 * MiB;
constexpr size_t WS_ATT = 64 * MiB;
constexpr size_t WS_XB = 128 * MiB;
constexpr size_t WS_R = 512 * MiB;
constexpr size_t WS_Q = WS_R, WS_K = WS_R + 128 * MiB, WS_V = WS_R + 160 * MiB, WS_O = WS_R + 192 * MiB;
constexpr size_t WS_GQ = WS_R, WS_GK = WS_R + 64 * MiB, WS_GV = WS_R + 128 * MiB, WS_GR = WS_R + 256 * MiB, WS_QEB = WS_R + 384 * MiB, WS_KDB = WS_R + 448 * MiB;
constexpr size_t WS_END = 1024 * MiB;
constexpr int MISC_OFF = 147456;
constexpr int LDS_BYTES = 147456 + 256;

#define GAS __attribute__((address_space(1)))
#define LAS __attribute__((address_space(3)))
typedef unsigned short bf16;
typedef unsigned v4u __attribute__((ext_vector_type(4)));
typedef unsigned v2u __attribute__((ext_vector_type(2)));
typedef float f32x4 __attribute__((ext_vector_type(4)));
typedef float f32x2 __attribute__((ext_vector_type(2)));
typedef short bf16x8 __attribute__((ext_vector_type(8)));
#define DI __device__ __forceinline__
DI unsigned f2bf(float f) { unsigned u = __builtin_bit_cast(unsigned, f); return (u + 0x7fffu + ((u >> 16) & 1u)) >> 16; }
DI unsigned pk2(float lo, float hi) { return f2bf(lo) | (f2bf(hi) << 16); }
DI float bf2f(unsigned short h) { return __builtin_bit_cast(float, (unsigned)h << 16); }
DI float bflo(unsigned w) { return __builtin_bit_cast(float, w << 16); }
DI float bfhi(unsigned w) { return __builtin_bit_cast(float, w & 0xffff0000u); }
DI float wave_sum(float v) {
#pragma unroll
    for (int o = 1; o < 64; o <<= 1) v += __shfl_xor(v, o);
    return v;
}

DI int rope_dest(int c) { const int hh = c >> 6, dd = c & 63, n = dd >> 5, d1 = dd & 31; return (hh << 6) + 8 * (d1 >> 2) + 4 * n + (d1 & 3); }
DI int hid_perm(int c) { return (c & ~255) + 64 * ((c >> 5) & 3) + 32 * ((c >> 7) & 1) + (c & 31); }
DI void p0_transpose_item(const float* W, int K, int N, bf16* WT, int rope_cols, LAS float* scr, int item, int lane, const float* gv = nullptr, const float* bv = nullptr, float* cs = nullptr, float* cb = nullptr, bool hperm = false) {
    const int nblk = N / 32, kb = item / nblk, nb = item % nblk, k0 = 64 * kb, n0 = 32 * nb;
    float csp = 0.f, cbp = 0.f;
#pragma unroll 8
    for (int i = 0; i < 32; ++i) { const int kk = 2 * i + (lane >> 5); float w = W[(size_t)(k0 + kk) * N + n0 + (lane & 31)];
        if (gv) { cbp += bv[k0 + kk] * w; w *= gv[k0 + kk]; csp += __builtin_bit_cast(float, f2bf(w) << 16); }
        scr[kk * 33 + (lane & 31)] = w; }
    if (gv) { __hip_atomic_fetch_add(cs + n0 + (lane & 31), csp, __ATOMIC_RELAXED, __HIP_MEMORY_SCOPE_AGENT); __hip_atomic_fetch_add(cb + n0 + (lane & 31), cbp, __ATOMIC_RELAXED, __HIP_MEMORY_SCOPE_AGENT); }
    asm volatile("s_waitcnt lgkmcnt(0)" ::: "memory");
    const int c = lane & 7;
#pragma unroll
    for (int j = 0; j < 4; ++j) { const int n = (lane >> 3) + 8 * j; const LAS float* s = scr + (8 * c) * 33 + n;
        v4u o; o.x = pk2(s[0 * 33], s[1 * 33]); o.y = pk2(s[2 * 33], s[3 * 33]); o.z = pk2(s[4 * 33], s[5 * 33]); o.w = pk2(s[6 * 33], s[7 * 33]);
        const int col = n0 + n; const int drow = col < rope_cols ? rope_dest(col) : col;
        const int kd = hperm ? hid_perm(k0 + 8 * c) : k0 + 8 * c;
        *(v4u*)(WT + (size_t)drow * K + kd) = o; }
    asm volatile("s_waitcnt lgkmcnt(0)" ::: "memory");
}
struct Args { const float* in[18]; float* out; unsigned char* ws; int ph_lo, ph_hi; };

DI void p0_prologue(const Args& a, LAS unsigned char* lds, int gw, int NGW, int wave, int lane) {
    LAS float* scr = (LAS float*)(lds + wave * 16384);
    unsigned char* ws = a.ws;
    constexpr int I_AIN = (DM / 64) * (A_IN / 32), I_SQ = (DM / 64) * (DM / 32), I_GIN = (DM / 64) * (G_IN / 32), I_1 = (DM / 64) * (FF / 32), I_2 = (FF / 64) * (DM / 32);
    constexpr int NITEMS = I_AIN + 2 * I_SQ + I_GIN + 2 * I_1 + 2 * I_2;
    for (int it = gw; it < NITEMS; it += NGW) {
        int r = it;
        if (r < I_AIN) { p0_transpose_item(a.in[2], DM, A_IN, (bf16*)(ws + WS_WAIN), 1280, scr, r, lane); continue; } r -= I_AIN;
        if (r < I_SQ) { p0_transpose_item(a.in[4], DM, DM, (bf16*)(ws + WS_WAOUT), 0, scr, r, lane); continue; } r -= I_SQ;
        if (r < I_GIN) { p0_transpose_item(a.in[5], DM, G_IN, (bf16*)(ws + WS_WGIN), 0, scr, r, lane, a.in[16], a.in[17], (float*)(ws + WS_FOLD + 32768), (float*)(ws + WS_FOLD + 49152)); continue; } r -= I_GIN;
        if (r < I_SQ) { p0_transpose_item(a.in[11], DM, DM, (bf16*)(ws + WS_WGOUT), 0, scr, r, lane); continue; } r -= I_SQ;
        if (r < 2 * I_1) { const int l = r / I_1; p0_transpose_item(a.in[14] + (size_t)l * DM * FF, DM, FF, (bf16*)(ws + WS_W1 + l * 8 * MiB), 0, scr, r % I_1, lane, a.in[12] + l * DM, a.in[13] + l * DM, (float*)(ws + WS_FOLD + (l ? 65536 : 0)), (float*)(ws + WS_FOLD + (l ? 81920 : 16384))); continue; } r -= 2 * I_1;
        { const int l = r / I_2; p0_transpose_item(a.in[15] + (size_t)l * DM * FF, FF, DM, (bf16*)(ws + WS_W2 + l * 8 * MiB), 0, scr, r % I_2, lane, nullptr, nullptr, nullptr, nullptr, true); }
    }
    { v4u* z = (v4u*)(ws + WS_WGIN + (size_t)G_IN * DM * 2); const int n16 = (G_INP - G_IN) * DM * 2 / 16;
      for (int i = gw * 64 + lane; i < n16; i += NGW * 64) z[i] = (v4u){0u, 0u, 0u, 0u}; }
    { const f32x4* x4 = (const f32x4*)a.in[0]; v2u* o = (v2u*)(ws + WS_XB); const int n4 = M * DM / 4, step = NGW * 64;
      for (int i = gw * 64 + lane; i < n4; i += 8 * step) { f32x4 v[8];
#pragma unroll
          for (int k = 0; k < 8; ++k) v[k] = x4[(i + k * step < n4) ? i + k * step : i];
#pragma unroll
          for (int k = 0; k < 8; ++k) if (i + k * step < n4) o[i + k * step] = (v2u){pk2(v[k].x, v[k].y), pk2(v[k].z, v[k].w)}; } }
    { f32x4* z4 = (f32x4*)(ws + WS_ST4); for (int i = gw * 64 + lane; i < M * 2 / 4; i += NGW * 64) z4[i] = (f32x4){0.f, 0.f, 0.f, 0.f}; }
    { const int* pos = (const int*)a.in[1]; float* ct = (float*)(ws + WS_COS); float* st = (float*)(ws + WS_SIN);
      for (int i = gw * 64 + lane; i < M * 32; i += NGW * 64) { const int row = i >> 5, f = i & 31;
          const float inv = (float)exp(-(double)f * (9.210340371976184 / 32.0));
          const float ang = (float)pos[row] * inv;
          const double ad = (double)ang; const double k = rint(ad * 0.15915494309189535); const float r = (float)(ad - k * 6.283185307179586);
          ct[i] = cosf(r); st[i] = sinf(r); } }
}

DI void ln_final_pass(const bf16* ZB, const float* ST, const float* g, const float* b, float* out, int gw, int NGW, int lane) {
    f32x4 gv[2][2], bv[2][2];
#pragma unroll
    for (int j = 0; j < 2; ++j)
#pragma unroll
        for (int n = 0; n < 2; ++n) { gv[j][n] = *(const f32x4*)(g + 8 * lane + 512 * j + 4 * n); bv[j][n] = *(const f32x4*)(b + 8 * lane + 512 * j + 4 * n); }
    for (int m = 4 * gw; m < M; m += 4 * NGW) {
        v4u v[4][2]; f32x2 st[4];
#pragma unroll
        for (int r = 0; r < 4; ++r) { st[r] = *(const f32x2*)(ST + 2 * (size_t)(m + r));
#pragma unroll
            for (int j = 0; j < 2; ++j) v[r][j] = *(const v4u*)(ZB + (size_t)(m + r) * DM + 8 * lane + 512 * j); }
#pragma unroll
        for (int r = 0; r < 4; ++r) { const float mean = st[r].x * (1.f / DM), rstd = __builtin_amdgcn_rsqf(st[r].y * (1.f / DM) - mean * mean + LN_EPS);
#pragma unroll
            for (int j = 0; j < 2; ++j) { const v4u w = v[r][j];
                const f32x4 x0 = {bflo(w.x), bfhi(w.x), bflo(w.y), bfhi(w.y)}, x1 = {bflo(w.z), bfhi(w.z), bflo(w.w), bfhi(w.w)};
                float* o = out + (size_t)(m + r) * DM + 8 * lane + 512 * j;
                *(f32x4*)o = (x0 - mean) * rstd * gv[j][0] + bv[j][0]; *(f32x4*)(o + 4) = (x1 - mean) * rstd * gv[j][1] + bv[j][1]; } }
    }
}

DI void gla_norm_pass(const bf16* OF, const bf16* OB, const bf16* Gr, const float* ng, bf16* Y, int gw, int NGW, int lane) {
    float g16[16];
#pragma unroll
    for (int i = 0; i < 16; ++i) g16[i] = ng[(lane & 15) * 16 + i];
    v4u a0, a1, b0, b1, r0, r1;
#define GN_LOAD(m_) do { const size_t off_ = (size_t)(m_) * GVC + lane * 16; a0 = *(const v4u*)(OF + off_); a1 = *(const v4u*)(OF + off_ + 8); b0 = *(const v4u*)(OB + off_); b1 = *(const v4u*)(OB + off_ + 8); r0 = *(const v4u*)(Gr + off_); r1 = *(const v4u*)(Gr + off_ + 8); } while (0)
    if (gw < M) GN_LOAD(gw);
    for (int m = gw; m < M; m += NGW) {
        const size_t off = (size_t)m * GVC + lane * 16;
        float o[16], r[16];
        const unsigned aw[8] = {a0.x, a0.y, a0.z, a0.w, a1.x, a1.y, a1.z, a1.w}, bw[8] = {b0.x, b0.y, b0.z, b0.w, b1.x, b1.y, b1.z, b1.w}, rw[8] = {r0.x, r0.y, r0.z, r0.w, r1.x, r1.y, r1.z, r1.w};
        { const int mn = (m + NGW < M) ? m + NGW : m; GN_LOAD(mn); }
        float ss = 0.f;
#pragma unroll
        for (int i = 0; i < 8; ++i) { o[2 * i] = bflo(aw[i]) + bflo(bw[i]); o[2 * i + 1] = bfhi(aw[i]) + bfhi(bw[i]); r[2 * i] = bflo(rw[i]); r[2 * i + 1] = bfhi(rw[i]); ss += o[2 * i] * o[2 * i] + o[2 * i + 1] * o[2 * i + 1]; }
        ss += __shfl_xor(ss, 1); ss += __shfl_xor(ss, 2); ss += __shfl_xor(ss, 4); ss += __shfl_xor(ss, 8);
        const float rs = __builtin_amdgcn_rsqf(ss * (1.f / GDV) + HN_EPS);
        unsigned w[8];
#pragma unroll
        for (int i = 0; i < 8; ++i) { const float x0 = o[2 * i] * rs * g16[2 * i], x1 = o[2 * i + 1] * rs * g16[2 * i + 1];
            const float s0 = r[2 * i] * __builtin_amdgcn_rcpf(1.f + __builtin_amdgcn_exp2f(-r[2 * i] * LOG2E)), s1 = r[2 * i + 1] * __builtin_amdgcn_rcpf(1.f + __builtin_amdgcn_exp2f(-r[2 * i + 1] * LOG2E)); w[i] = pk2(x0 * s0, x1 * s1); }
        *(v4u*)(Y + off) = (v4u){w[0], w[1], w[2], w[3]}; *(v4u*)(Y + off + 8) = (v4u){w[4], w[5], w[6], w[7]};
    }
#undef GN_LOAD
}

#define XB_TMO      128
#define XB_XCNT(j)  (256  + 64 * (j))
#define XB_XSUB(j)  (1280 + 64 * (j))
#define XB_XGEN(j)  (2304 + 64 * (j))
#define XB_TOP      3328
#define XB_TOPGEN   3392
#define XCD_BAR_WORDS 3456
#define XB_SPIN_CAP (1u << 18)

__device__ __forceinline__ unsigned xb_ld(unsigned* p)              { return __hip_atomic_load(p, __ATOMIC_RELAXED, __HIP_MEMORY_SCOPE_AGENT); }
__device__ __forceinline__ unsigned xb_add(unsigned* p, unsigned v) { return __hip_atomic_fetch_add(p, v, __ATOMIC_RELAXED, __HIP_MEMORY_SCOPE_AGENT); }
__device__ __forceinline__ unsigned xb_xcc_id() { return (unsigned)__builtin_amdgcn_s_getreg((3 << 11) | 20) & 0xFu; }
#define XB_SPIN(cond, bar) do { unsigned _sp = 0; while (cond) { __builtin_amdgcn_s_sleep(1); \
    if ((++_sp & 255u) == 0u) { if (xb_ld(&(bar)[XB_TMO])) break; if (_sp > XB_SPIN_CAP) { atomicAdd(&(bar)[XB_TMO], 1u); break; } } } } while (0)

struct XcdBarrier {
    unsigned* bar; unsigned x;
    volatile LAS unsigned* st;
};

__device__ __forceinline__ XcdBarrier xcd_barrier_post(unsigned* bar, volatile LAS unsigned* st) {
    XcdBarrier b; b.bar = bar; b.x = xb_xcc_id(); b.st = st;
    if (threadIdx.x == 0) (void)xb_add(&bar[XB_XCNT(b.x)], 1u);
    return b;
}
__device__ __forceinline__ void xcd_barrier_complete(unsigned* bar, unsigned x, unsigned& nloc, unsigned& nx) {
    const unsigned G = gridDim.x * gridDim.y * gridDim.z;
    unsigned sum, cnt, mine, sp = 0u;
    for (;;) {
        sum = 0u; cnt = 0u; mine = 0u;
#pragma unroll
        for (unsigned j = 0; j < 16; ++j) { const unsigned c = xb_ld(&bar[XB_XCNT(j)]); sum += c; cnt += (c > 0u) ? 1u : 0u; mine = (j == x) ? c : mine; }
        if (sum == G) break;
        __builtin_amdgcn_s_sleep(1);
        if ((++sp & 255u) == 0u) { if (xb_ld(&bar[XB_TMO])) break; if (sp > XB_SPIN_CAP) { atomicAdd(&bar[XB_TMO], 1u); break; } }
    }
    nloc = mine > 0u ? mine : 1u; nx = cnt > 0u ? cnt : 1u;
}

__device__ __forceinline__ void xcd_barrier(const XcdBarrier& b) {
    asm volatile("s_waitcnt vmcnt(0)" ::: "memory");
    __syncthreads();
    if (threadIdx.x == 0) {
        unsigned* bar = b.bar;
        __builtin_amdgcn_s_waitcnt(0);
        unsigned nloc = b.st[0], nx = b.st[1];
        if (nloc == 0u) { xcd_barrier_complete(bar, b.x, nloc, nx); b.st[0] = nloc; b.st[1] = nx; }
        const unsigned old = xb_add(&bar[XB_XSUB(b.x)], 1u);
        const unsigned gen = old / nloc;
        if (old + 1u == (gen + 1u) * nloc) {
            __builtin_amdgcn_fence(__ATOMIC_RELEASE, "agent");
            asm volatile("s_waitcnt vmcnt(0)" ::: "memory");
            const unsigned og = xb_add(&bar[XB_TOP], 1u);
            const unsigned tg = og / nx;
            if (og + 1u == (tg + 1u) * nx) xb_add(&bar[XB_TOPGEN], 1u);
            else XB_SPIN(xb_ld(&bar[XB_TOPGEN]) == tg, bar);
            __builtin_amdgcn_fence(__ATOMIC_ACQUIRE, "agent");
            xb_add(&bar[XB_XGEN(b.x)], 1u);
            asm volatile("s_waitcnt vmcnt(0)" ::: "memory");
        } else {
            XB_SPIN(xb_ld(&bar[XB_XGEN(b.x)]) == gen, bar);
            __builtin_amdgcn_fence(__ATOMIC_ACQUIRE, "agent");
            asm volatile("s_waitcnt vmcnt(0)" ::: "memory");
        }
    }
    __syncthreads();
}
typedef float f32x16 __attribute__((ext_vector_type(16)));
typedef short s16x4 __attribute__((ext_vector_type(4)));
typedef __bf16 bf16x2_t __attribute__((ext_vector_type(2)));
DI unsigned cvtpk(float lo, float hi) { f32x2 v = {lo, hi}; bf16x2_t b = __builtin_convertvector(v, bf16x2_t); return __builtin_bit_cast(unsigned, b); }
DI s16x4 tr_read(const LAS unsigned char* p) { return __builtin_bit_cast(s16x4, __builtin_amdgcn_ds_read_tr16_b64_v4i16((LAS s16x4*)p)); }
DI int crow(int reg, int h) { return (reg & 3) + 8 * (reg >> 2) + 4 * h; }
DI bf16x8 pack_step(const f32x16& x, int s) { v4u p; p.x = cvtpk(x[8 * s], x[8 * s + 1]); p.y = cvtpk(x[8 * s + 2], x[8 * s + 3]); p.z = cvtpk(x[8 * s + 4], x[8 * s + 5]); p.w = cvtpk(x[8 * s + 6], x[8 * s + 7]); return __builtin_bit_cast(bf16x8, p); }
#define MFMA32(a, b, c) __builtin_amdgcn_mfma_f32_32x32x16_bf16((a), (b), (c), 0, 0, 0)
#define MFMA16(a, b, c) __builtin_amdgcn_mfma_f32_16x16x32_bf16((a), (b), (c), 0, 0, 0)
constexpr int ATT_KP = 144, ATT_VP = 144, ATT_V_OFF = 512 * ATT_KP;
static_assert(ATT_V_OFF + 512 * ATT_VP <= 147456, "attention LDS");

DI void attn_mfma(const bf16* Q, const bf16* Kb, const bf16* Vb, bf16* O, const float* sink, LAS unsigned char* lds, int blk, int G, int tid) {
    const int lane = tid & 63, wave = __builtin_amdgcn_readfirstlane(tid >> 6), r32 = lane & 31, h = lane >> 5, i16 = lane & 15, blk16 = (lane >> 4) & 1;
    const int hl = wave >> 1, qloc = (wave & 1) * 64;
    const int vblk = (G % 8 == 0) ? (blk % 8) * (G / 8) + blk / 8 : blk;
    for (int run = vblk; run < NB * AKV * 8; run += G) {
        const int b = run >> 5, kvh = (run >> 3) & 3, qb0 = (run & 7) * 8;
        const int head = kvh * 4 + hl;
        const bf16* Kg = Kb + (size_t)b * SEQ * 256 + kvh * 64; const bf16* Vg = Vb + (size_t)b * SEQ * 256 + kvh * 64;
        __syncthreads();
#pragma unroll
        for (int i = 0; i < 6; ++i) { const int c = tid + 512 * i, r = c >> 3, ch = c & 7, kpos = 128 * (qb0 - 1) + r;
            v4u kv = {0u, 0u, 0u, 0u}, vv = {0u, 0u, 0u, 0u};
            if (kpos >= 0 && kpos < SEQ) { kv = *(const v4u*)(Kg + (size_t)kpos * 256 + ch * 8); vv = *(const v4u*)(Vg + (size_t)kpos * 256 + ch * 8); }
            *(LAS v4u*)(lds + (kpos & 511) * ATT_KP + ch * 16) = kv; *(LAS v4u*)(lds + ATT_V_OFF + (kpos & 511) * ATT_VP + ch * 16) = vv; }
        bf16x8 qf[2][4];
        { const size_t qrow0 = (size_t)b * SEQ + qb0 * 128 + qloc;
#pragma unroll
          for (int q2 = 0; q2 < 2; ++q2)
#pragma unroll
              for (int ks = 0; ks < 4; ++ks) qf[q2][ks] = *(const bf16x8*)(Q + (qrow0 + 32 * q2 + r32) * 1024 + head * 64 + 16 * ks + 8 * h); }
        const float m0 = sink[head] * LOG2E;
        __syncthreads();
        for (int j = 0; j < 8; ++j) {
            const int qb = qb0 + j; const int qp0 = qb * 128 + qloc; const size_t qrow0 = (size_t)b * SEQ + qp0;
            v4u pk[2], pv[2]; bf16x8 qn[2][4];
            const int nk0 = 128 * (qb + 2); const bool pf = (j < 7) && (nk0 < SEQ);
#pragma unroll
            for (int i = 0; i < 2; ++i) { const int c = tid + 512 * i, r = c >> 3, ch = c & 7; const int kpos = pf ? nk0 + r : 0;
                pk[i] = *(const v4u*)(Kg + (size_t)kpos * 256 + ch * 8); pv[i] = *(const v4u*)(Vg + (size_t)kpos * 256 + ch * 8); }
            { const size_t qrn = (j < 7) ? qrow0 + 128 : qrow0;
#pragma unroll
              for (int q2 = 0; q2 < 2; ++q2)
#pragma unroll
                  for (int ks = 0; ks < 4; ++ks) qn[q2][ks] = *(const bf16x8*)(Q + (qrn + 32 * q2 + r32) * 1024 + head * 64 + 16 * ks + 8 * h); }
            f32x16 oT[2][2];
#pragma unroll
            for (int a = 0; a < 2; ++a)
#pragma unroll
                for (int c = 0; c < 2; ++c)
#pragma unroll
                    for (int i = 0; i < 16; ++i) oT[a][c][i] = 0.f;
            float mrun[2] = {m0, m0}; float lrun[2]; lrun[0] = lrun[1] = (h == 0) ? 1.f : 0.f;
            for (int kt = 0; kt < 10; ++kt) {
                const int kp0 = qp0 - 128 + 32 * kt, kr0 = kp0 & 511;
                bf16x8 kf[4];
#pragma unroll
                for (int ks = 0; ks < 4; ++ks) kf[ks] = *(const LAS bf16x8*)(lds + (kr0 + r32) * ATT_KP + (16 * ks + 8 * h) * 2);
                f32x16 sT[2];
#pragma unroll
                for (int q2 = 0; q2 < 2; ++q2) {
#pragma unroll
                    for (int i = 0; i < 16; ++i) sT[q2][i] = 0.f;
#pragma unroll
                    for (int ks = 0; ks < 4; ++ks) sT[q2] = MFMA32(kf[ks], qf[q2][ks], sT[q2]);
                }
                const bool full = (kp0 >= 0) && (kp0 + 31 < SEQ) && (qp0 + 63 - kp0 <= 128) && (kp0 + 31 - qp0 <= 128);
                if (!full) {
#pragma unroll
                    for (int q2 = 0; q2 < 2; ++q2) { const int qpos = qp0 + 32 * q2 + r32;
#pragma unroll
                        for (int i = 0; i < 16; ++i) { const int kpos = kp0 + crow(i, h), dl = qpos - kpos; if (kpos < 0 || kpos >= SEQ || dl > 128 || dl < -128) sT[q2][i] = -INFINITY; } }
                }
#pragma unroll
                for (int q2 = 0; q2 < 2; ++q2) {
                    float mx = sT[q2][0];
#pragma unroll
                    for (int i = 1; i < 16; ++i) mx = fmaxf(mx, sT[q2][i]);
                    mx = fmaxf(mx, __shfl_xor(mx, 32));
                    float mref = mrun[q2];
                    if (__any(mx > mref + 6.f)) { const float mn = fmaxf(mref, mx), corr = __builtin_amdgcn_exp2f(mref - mn); mrun[q2] = mn; mref = mn; lrun[q2] *= corr;
#pragma unroll
                        for (int db = 0; db < 2; ++db)
#pragma unroll
                            for (int i = 0; i < 16; ++i) oT[db][q2][i] *= corr; }
                    float ps = 0.f;
#pragma unroll
                    for (int i = 0; i < 16; ++i) { const float p = __builtin_amdgcn_exp2f(sT[q2][i] - mref); sT[q2][i] = p; ps += p; }
                    lrun[q2] += ps;
                }
#pragma unroll
                for (int s = 0; s < 2; ++s) {
                    bf16x8 pf2[2]; pf2[0] = pack_step(sT[0], s); pf2[1] = pack_step(sT[1], s);
#pragma unroll
                    for (int db = 0; db < 2; ++db) {
                        const LAS unsigned char* vp = lds + ATT_V_OFF + (kr0 + 16 * s + 4 * h + (i16 >> 2)) * ATT_VP + (32 * db + 16 * blk16 + 4 * (i16 & 3)) * 2;
                        const s16x4 lo = tr_read(vp), hi = tr_read(vp + 8 * ATT_VP);
                        const bf16x8 vf = __builtin_shufflevector(lo, hi, 0, 1, 2, 3, 4, 5, 6, 7);
                        oT[db][0] = MFMA32(vf, pf2[0], oT[db][0]); oT[db][1] = MFMA32(vf, pf2[1], oT[db][1]);
                    }
                }
            }
#pragma unroll
            for (int q2 = 0; q2 < 2; ++q2) { const float lt = lrun[q2] + __shfl_xor(lrun[q2], 32), rl = 1.f / lt;
                bf16* op = O + (qrow0 + 32 * q2 + r32) * 1024 + head * 64 + 4 * h;
#pragma unroll
                for (int db = 0; db < 2; ++db)
#pragma unroll
                    for (int g4 = 0; g4 < 4; ++g4) *(v2u*)(op + 32 * db + 8 * g4) = (v2u){cvtpk(oT[db][q2][4 * g4] * rl, oT[db][q2][4 * g4 + 1] * rl), cvtpk(oT[db][q2][4 * g4 + 2] * rl, oT[db][q2][4 * g4 + 3] * rl)}; }
            if (j < 7) {
#pragma unroll
                for (int i = 0; i < 2; ++i) { const int c = tid + 512 * i, r = c >> 3, ch = c & 7; const int lr = (nk0 + r) & 511;
                    *(LAS v4u*)(lds + lr * ATT_KP + ch * 16) = pf ? pk[i] : (v4u){0u, 0u, 0u, 0u}; *(LAS v4u*)(lds + ATT_V_OFF + lr * ATT_VP + ch * 16) = pf ? pv[i] : (v4u){0u, 0u, 0u, 0u}; }
#pragma unroll
                for (int q2 = 0; q2 < 2; ++q2)
#pragma unroll
                    for (int ks = 0; ks < 4; ++ks) qf[q2][ks] = qn[q2][ks];
            }
            __syncthreads();
        }
    }
}
constexpr int GP = 272;
constexpr int PREP_QE = 0, PREP_KE = 64 * GP, PREP_KD = 2 * 64 * GP, PREP_Q = 3 * 64 * GP, PREP_K = 4 * 64 * GP, PREP_LR = 5 * 64 * GP, PREP_BS = PREP_LR + 64 * 32 * 4, PREP_END = PREP_BS + 4 * 128 * 4;
static_assert(PREP_END <= 131072, "prep LDS");
DI float logsig2(float z) { return fminf(z, 0.f) * LOG2E - __builtin_amdgcn_logf(1.f + __builtin_amdgcn_exp2f(-fabsf(z) * LOG2E)); }
DI unsigned short cvt1(float x) { return (unsigned short)cvtpk(x, 0.f); }
DI void gla_prep(bf16* Gq, bf16* Gk, bf16* QEB, bf16* KDB, const float* LR, const float* w2f, const float* gbf, const float* w2b, const float* gbb, float* DL, bf16* ATT,
                 LAS unsigned char* lds, int blk, int G, int tid) {
    const int lane = tid & 63, wave = __builtin_amdgcn_readfirstlane(tid >> 6), d = tid & 127, tq = tid >> 7, fr = lane & 15, quad = lane >> 4;
    LAS float* lrs = (LAS float*)(lds + PREP_LR); LAS float* bs = (LAS float*)(lds + PREP_BS);
    for (int it = blk; it < NB * GH * 128; it += G) {
        const int h = it & 3, c = (it >> 2) & 127, b = it >> 9; const size_t row0 = (size_t)b * SEQ + 64 * c;
        const int unit = (b * GH + h) * 128 + c;
        __syncthreads();
        ((LAS f32x4*)lrs)[tid] = ((const f32x4*)(LR + row0 * 32))[tid];
#pragma unroll
        for (int i = 0; i < 2; ++i) { const int p = tid + 512 * i, r = p >> 4, ch = p & 15; const size_t o = (row0 + r) * GQK + h * 128 + ch * 8;
            *(LAS v4u*)(lds + PREP_Q + r * GP + ch * 16) = *(const v4u*)(Gq + o); *(LAS v4u*)(lds + PREP_K + r * GP + ch * 16) = *(const v4u*)(Gk + o); }
        __syncthreads();
#pragma unroll 1
        for (int dir = 0; dir < 2; ++dir) {
            const float* w2 = dir ? w2b : w2f; const float bias = (dir ? gbb : gbf)[h * 128 + d];
            float w2c[16];
#pragma unroll
            for (int r = 0; r < 16; ++r) w2c[r] = w2[r * GQK + h * 128 + d];
            float bl[16];
#pragma unroll
            for (int i = 0; i < 16; ++i) { const LAS f32x4* l4 = (const LAS f32x4*)(lrs + (16 * tq + i) * 32 + dir * 16); float z = bias;
#pragma unroll
                for (int r4 = 0; r4 < 4; ++r4) { const f32x4 x = l4[r4]; z += x.x * w2c[4 * r4] + x.y * w2c[4 * r4 + 1] + x.z * w2c[4 * r4 + 2] + x.w * w2c[4 * r4 + 3]; }
                bl[i] = logsig2(z) * (1.f / 16.f); }
            if (dir == 0) {
#pragma unroll
                for (int i = 1; i < 16; ++i) bl[i] += bl[i - 1];
                bs[tq * 128 + d] = bl[15];
            } else {
#pragma unroll
                for (int i = 14; i >= 0; --i) bl[i] += bl[i + 1];
                bs[tq * 128 + d] = bl[0];
            }
            __syncthreads();
            const float s0 = bs[d], s1 = bs[128 + d], s2 = bs[256 + d], s3 = bs[384 + d]; const float blast = (s0 + s1) + (s2 + s3);
            float pre;
            if (dir == 0) pre = (tq > 0 ? s0 : 0.f) + (tq > 1 ? s1 : 0.f) + (tq > 2 ? s2 : 0.f);
            else pre = (tq < 3 ? s3 : 0.f) + (tq < 2 ? s2 : 0.f) + (tq < 1 ? s1 : 0.f);
            const float elast = __builtin_amdgcn_exp2f(blast);
#pragma unroll
            for (int i = 0; i < 16; ++i) { const int t = 16 * tq + i; const float eb = __builtin_amdgcn_exp2f(pre + bl[i]);
                const float qv = bf2f(*(const LAS unsigned short*)(lds + PREP_Q + t * GP + d * 2)), kv = bf2f(*(const LAS unsigned short*)(lds + PREP_K + t * GP + d * 2));
                const float ke = kv * __builtin_amdgcn_rcpf(eb);
                *(LAS unsigned short*)(lds + PREP_QE + t * GP + d * 2) = cvt1(qv * eb); *(LAS unsigned short*)(lds + PREP_KE + t * GP + d * 2) = cvt1(ke); *(LAS unsigned short*)(lds + PREP_KD + t * GP + d * 2) = cvt1(ke * elast); }
            if (tq == 0) DL[((size_t)dir * (NB * GH * 128) + unit) * 128 + d] = elast;
            __syncthreads();
            { bf16* QEo = dir ? QEB : Gq; bf16* KDo = dir ? KDB : Gk;
#pragma unroll
              for (int i = 0; i < 2; ++i) { const int p = tid + 512 * i, r = p >> 4, ch = p & 15; const size_t o = (row0 + r) * GQK + h * 128 + ch * 8;
                  *(v4u*)(QEo + o) = *(const LAS v4u*)(lds + PREP_QE + r * GP + ch * 16); *(v4u*)(KDo + o) = *(const LAS v4u*)(lds + PREP_KD + r * GP + ch * 16); } }
            const int tt = wave & 3;
            bf16x8 qf[4];
#pragma unroll
            for (int ks = 0; ks < 4; ++ks) qf[ks] = *(const LAS bf16x8*)(lds + PREP_QE + (16 * tt + fr) * GP + (32 * ks + 8 * quad) * 2);
            bf16* attp = ATT + ((size_t)dir * (NB * GH * 128) + unit) * 4096;
#pragma unroll
            for (int j = 0; j < 2; ++j) { const int st = 2 * (wave >> 2) + j; f32x4 acc = {0.f, 0.f, 0.f, 0.f};
#pragma unroll
                for (int ks = 0; ks < 4; ++ks) { const bf16x8 kf = *(const LAS bf16x8*)(lds + PREP_KE + (16 * st + fr) * GP + (32 * ks + 8 * quad) * 2); acc = MFMA16(kf, qf[ks], acc); }
                const int t = 16 * tt + fr, sb = 16 * st + 4 * quad;
#pragma unroll
                for (int jj = 0; jj < 4; ++jj) { const int s = sb + jj; const bool keep = dir ? (s >= t) : (s <= t); if (!keep) acc[jj] = 0.f; }
                *(v2u*)(attp + t * 64 + sb) = (v2u){cvtpk(acc[0], acc[1]), cvtpk(acc[2], acc[3])}; }
            __syncthreads();
        }
    }
}

constexpr int SC_AP = 144, SC_VP = 144;
constexpr int SC_ATT = 0, SC_QE = 64 * SC_AP, SC_KD = SC_QE + 64 * GP, SC_V = SC_KD + 64 * GP, SC_DL = SC_V + 64 * SC_VP, SC_BUF = SC_DL + 512, SC_ST = 2 * SC_BUF, SC_END = SC_ST + 64 * GP;
static_assert(SC_END <= 131072, "scan LDS");
DI void gla_scan(const bf16* QEF, const bf16* QEB, const bf16* KDF, const bf16* KDB, const bf16* Gv, const float* DL, const bf16* ATT, bf16* OF, bf16* OB, LAS unsigned char* lds, int blk, int G, int tid) {
    const int lane = tid & 63, wave = __builtin_amdgcn_readfirstlane(tid >> 6), fr = lane & 15, quad = lane >> 4;
    const int vblk = (G % 8 == 0) ? (blk % 8) * (G / 8) + blk / 8 : blk;
    for (int u = vblk; u < NB * GH * 2 * 4; u += G) {
        const int dvs = u & 3, dir = (u >> 2) & 1, h = (u >> 3) & 3, b = u >> 5;
        const bf16* QE = dir ? QEB : QEF; const bf16* KD = dir ? KDB : KDF; bf16* OUT = dir ? OB : OF;
        const float* DLu = DL + ((size_t)dir * (NB * GH * 128) + (b * GH + h) * 128) * 128; const bf16* ATTu = ATT + ((size_t)dir * (NB * GH * 128) + (b * GH + h) * 128) * 4096;
        f32x4 S[4];
#pragma unroll
        for (int n = 0; n < 4; ++n) S[n] = (f32x4){0.f, 0.f, 0.f, 0.f};
        v4u raA, rqA[2], rkA[2], rvA, rdA, raB, rqB[2], rkB[2], rvB, rdB;
        const int a_r = tid >> 3, a_c = tid & 7;
#define SC_LOAD(X, c_) do { const int cl_ = (c_) < 127 ? (c_) : 127; const int cc_ = dir ? 127 - cl_ : cl_; const size_t row0_ = (size_t)b * SEQ + 64 * cc_; \
            ra##X = *(const v4u*)(ATTu + (size_t)cc_ * 4096 + tid * 8); \
            rv##X = *(const v4u*)(Gv + (row0_ + a_r) * GVC + h * 256 + dvs * 64 + a_c * 8); \
            _Pragma("unroll") for (int i_ = 0; i_ < 2; ++i_) { const int p_ = tid + 512 * i_, r_ = p_ >> 4, c2_ = p_ & 15; \
                rq##X[i_] = *(const v4u*)(QE + (row0_ + r_) * GQK + h * 128 + c2_ * 8); rk##X[i_] = *(const v4u*)(KD + (row0_ + r_) * GQK + h * 128 + c2_ * 8); } \
            rd##X = *(const v4u*)(DLu + (size_t)cc_ * 128 + (tid & 31) * 4); } while (0)
#define SC_STORE(X, bufo) do { *(LAS v4u*)(lds + (bufo) + SC_ATT + a_r * SC_AP + a_c * 16) = ra##X; *(LAS v4u*)(lds + (bufo) + SC_V + a_r * SC_VP + a_c * 16) = rv##X; \
            _Pragma("unroll") for (int i_ = 0; i_ < 2; ++i_) { const int p_ = tid + 512 * i_, r_ = p_ >> 4, c2_ = p_ & 15; \
                *(LAS v4u*)(lds + (bufo) + SC_QE + r_ * GP + c2_ * 16) = rq##X[i_]; *(LAS v4u*)(lds + (bufo) + SC_KD + r_ * GP + c2_ * 16) = rk##X[i_]; } \
            if (tid < 32) *(LAS v4u*)(lds + (bufo) + SC_DL + tid * 16) = rd##X; } while (0)
#define SC_STEP(c_, bo) do { const int cc = dir ? 127 - (c_) : (c_); \
            _Pragma("unroll") for (int n = 0; n < 4; ++n) *(LAS v2u*)(lds + SC_ST + (16 * n + fr) * GP + (16 * wave + 4 * quad) * 2) = (v2u){cvtpk(S[n][0], S[n][1]), cvtpk(S[n][2], S[n][3])}; \
              \
            const int tt = wave & 3, nb = 2 * (wave >> 2); bf16x8 af[2], qf[4], vf[2][4], kf[2], sf[2][4]; \
            _Pragma("unroll") for (int ks = 0; ks < 2; ++ks) af[ks] = *(const LAS bf16x8*)(lds + (bo) + SC_ATT + (16 * tt + fr) * SC_AP + (32 * ks + 8 * quad) * 2); \
            _Pragma("unroll") for (int ks = 0; ks < 4; ++ks) qf[ks] = *(const LAS bf16x8*)(lds + (bo) + SC_QE + (16 * tt + fr) * GP + (32 * ks + 8 * quad) * 2); \
            _Pragma("unroll") for (int ks = 0; ks < 2; ++ks) { \
                _Pragma("unroll") for (int n = 0; n < 4; ++n) { const LAS unsigned char* vp = lds + (bo) + SC_V + (32 * ks + 8 * quad + (fr >> 2)) * SC_VP + (16 * n + 4 * (fr & 3)) * 2; \
                    const s16x4 lo = tr_read(vp), hi = tr_read(vp + 4 * SC_VP); vf[ks][n] = __builtin_shufflevector(lo, hi, 0, 1, 2, 3, 4, 5, 6, 7); } \
                const LAS unsigned char* kp = lds + (bo) + SC_KD + (32 * ks + 8 * quad + (fr >> 2)) * GP + (16 * wave + 4 * (fr & 3)) * 2; \
                const s16x4 klo = tr_read(kp), khi = tr_read(kp + 4 * GP); kf[ks] = __builtin_shufflevector(klo, khi, 0, 1, 2, 3, 4, 5, 6, 7); } \
            const f32x4 dl = *(const LAS f32x4*)(lds + (bo) + SC_DL + (16 * wave + 4 * quad) * 4); \
            __syncthreads(); \
            _Pragma("unroll") for (int j = 0; j < 2; ++j) _Pragma("unroll") for (int ks = 0; ks < 4; ++ks) sf[j][ks] = *(const LAS bf16x8*)(lds + SC_ST + (16 * (nb + j) + fr) * GP + (32 * ks + 8 * quad) * 2); \
            f32x4 acc0 = {0.f, 0.f, 0.f, 0.f}, acc1 = {0.f, 0.f, 0.f, 0.f}; \
            _Pragma("unroll") for (int ks = 0; ks < 2; ++ks) { acc0 = MFMA16((nb ? vf[ks][2] : vf[ks][0]), af[ks], acc0); acc1 = MFMA16((nb ? vf[ks][3] : vf[ks][1]), af[ks], acc1); } \
            _Pragma("unroll") for (int n = 0; n < 4; ++n) S[n] = S[n] * dl; \
            _Pragma("unroll") for (int ks = 0; ks < 2; ++ks) _Pragma("unroll") for (int n = 0; n < 4; ++n) S[n] = MFMA16(kf[ks], vf[ks][n], S[n]); \
            _Pragma("unroll") for (int ks = 0; ks < 4; ++ks) { acc0 = MFMA16(sf[0][ks], qf[ks], acc0); acc1 = MFMA16(sf[1][ks], qf[ks], acc1); } \
            { const size_t orow = (size_t)b * SEQ + 64 * cc + 16 * tt + fr; bf16* op = OUT + orow * GVC + h * 256 + dvs * 64 + 16 * nb + 4 * quad; \
              *(v2u*)op = (v2u){cvtpk(acc0[0], acc0[1]), cvtpk(acc0[2], acc0[3])}; *(v2u*)(op + 16) = (v2u){cvtpk(acc1[0], acc1[1]), cvtpk(acc1[2], acc1[3])}; } } while (0)
        __syncthreads();
        SC_LOAD(A, 0); SC_STORE(A, 0); SC_LOAD(A, 1);
        __syncthreads();
        for (int c = 0; c < 128; c += 2) {
            SC_LOAD(B, c + 2);
            SC_STEP(c, 0);
            SC_STORE(A, SC_BUF);
            __syncthreads();
            SC_LOAD(A, c + 3);
            SC_STEP(c + 1, SC_BUF);
            SC_STORE(B, 0);
            __syncthreads();
        }
#undef SC_STEP
#undef SC_LOAD
#undef SC_STORE
    }
}
enum Phase { PH_PRO = 0, PH_QKV, PH_ATT, PH_AOUT, PH_UP0, PH_DN0, PH_GIN, PH_GPREP, PH_GSCAN, PH_GNORM, PH_GOUT, PH_UP1, PH_DN1, PH_LN4, PH_COUNT };

__global__ void __launch_bounds__(NTHREADS, 2) fwd_kernel(Args a) {
    extern __shared__ __attribute__((aligned(16))) unsigned char lds_raw[];
    LAS unsigned char* lds = (LAS unsigned char*)lds_raw;
    cg::grid_group grid = cg::this_grid();
    const int tid = threadIdx.x, lane = tid & 63, wave = __builtin_amdgcn_readfirstlane(tid >> 6);
    const int G = gridDim.x, blk = blockIdx.x;
    const int gw = blk * NWAVES + wave, NGW = G * NWAVES;
    unsigned char* ws = a.ws;
    bf16* XB = (bf16*)(ws + WS_XB); float* ST1 = (float*)(ws + WS_ST1); float* ST2 = (float*)(ws + WS_ST2); float* ST3 = (float*)(ws + WS_ST3); float* FOLD = (float*)(ws + WS_FOLD);
    bf16* HB = (bf16*)(ws + WS_R);
    const int lo = a.ph_lo, hi = a.ph_hi;
    if (a.ph_lo < 0) grid.sync();
    if (tid < 32) ((LAS unsigned*)(lds + MISC_OFF))[tid] = 0u;
    __syncthreads();
    XcdBarrier bar = xcd_barrier_post((unsigned*)(ws + WS_CTL) + 1024, (volatile LAS unsigned*)(lds + MISC_OFF) + 8);
#define IN(k) (lo <= (k) && (k) < hi)
#define SEAM(k) do { if (IN(k) && IN((k) + 1)) xcd_barrier(bar); } while (0)
#define GEMM_RUN(EPI, g, S, E) pg8::gemm_phase<EPI, pg8::StaticOrder, PG8_ALIGN, PG8_SP2>(lds, g, S, E)
    if (IN(PH_PRO)) { p0_prologue(a, lds, gw, NGW, wave, lane); } SEAM(PH_PRO);
    if (IN(PH_QKV)) {
        pg8::Gemm g{XB, (const bf16*)(ws + WS_WAIN), M, A_IN, DM}; pg8::StaticOrder S; S.init(M, A_IN, G, blk);
        pg8::EpiQKV E{(bf16*)(ws + WS_Q), (bf16*)(ws + WS_K), (bf16*)(ws + WS_V), (const float*)(ws + WS_COS), (const float*)(ws + WS_SIN), 0.125f * LOG2E};
        GEMM_RUN(pg8::EpiQKV, g, S, E);
    } SEAM(PH_QKV);
    if (IN(PH_ATT)) { attn_mfma((const bf16*)(ws + WS_Q), (const bf16*)(ws + WS_K), (const bf16*)(ws + WS_V), (bf16*)(ws + WS_O), a.in[3], lds, blk, G, tid); } SEAM(PH_ATT);
    if (IN(PH_AOUT)) {
        pg8::Gemm g{(const bf16*)(ws + WS_O), (const bf16*)(ws + WS_WAOUT), M, DM, DM}; pg8::StaticOrder S; S.init(M, DM, G, blk);
        pg8::EpiRes<2> E{nullptr, XB, nullptr, nullptr, nullptr, XB, ST1};
        GEMM_RUN(pg8::EpiRes<2>, g, S, E);
    } SEAM(PH_AOUT);
    if (IN(PH_UP0)) {
        pg8::Gemm g{XB, (const bf16*)(ws + WS_W1), M, FF, DM}; pg8::StaticOrder S; S.init(M, FF, G, blk);
        pg8::EpiSqRelu E{HB, FF, pg8::LnFold{ST1, FOLD, FOLD + 4096}};
        GEMM_RUN(pg8::EpiSqRelu, g, S, E);
    } SEAM(PH_UP0);
    if (IN(PH_DN0)) {
        pg8::Gemm g{HB, (const bf16*)(ws + WS_W2), M, DM, FF}; pg8::StaticOrder S; S.init(M, DM, G, blk);
        pg8::EpiRes<1> E{nullptr, XB, ST1, a.in[12], a.in[13], XB, ST2};
        GEMM_RUN(pg8::EpiRes<1>, g, S, E);
    } SEAM(PH_DN0);
    if (IN(PH_GIN)) {
        pg8::Gemm g{XB, (const bf16*)(ws + WS_WGIN), M, G_INP, DM}; pg8::StaticOrder S; S.init(M, G_INP, G, blk);
        pg8::EpiGin E{(bf16*)(ws + WS_GQ), (bf16*)(ws + WS_GK), (bf16*)(ws + WS_GV), (bf16*)(ws + WS_GR), (float*)(ws + WS_LR), 0.08838834764831845f, pg8::LnFold{ST2, FOLD + 8192, FOLD + 12288}};
        GEMM_RUN(pg8::EpiGin, g, S, E);
    } SEAM(PH_GIN);
    if (IN(PH_GPREP)) {
        gla_prep((bf16*)(ws + WS_GQ), (bf16*)(ws + WS_GK), (bf16*)(ws + WS_QEB), (bf16*)(ws + WS_KDB), (const float*)(ws + WS_LR), a.in[6], a.in[7], a.in[8], a.in[9],
                 (float*)(ws + WS_DL), (bf16*)(ws + WS_ATT), lds, blk, G, tid);
    } SEAM(PH_GPREP);
    if (IN(PH_GSCAN)) {
        gla_scan((const bf16*)(ws + WS_GQ), (const bf16*)(ws + WS_QEB), (const bf16*)(ws + WS_GK), (const bf16*)(ws + WS_KDB), (const bf16*)(ws + WS_GV), (const float*)(ws + WS_DL), (const bf16*)(ws + WS_ATT),
                 (bf16*)a.out, (bf16*)a.out + (size_t)M * GVC, lds, blk, G, tid);
    } SEAM(PH_GSCAN);
    if (IN(PH_GNORM)) { gla_norm_pass((const bf16*)a.out, (const bf16*)a.out + (size_t)M * GVC, (const bf16*)(ws + WS_GR), a.in[10], (bf16*)a.out, gw, NGW, lane); } SEAM(PH_GNORM);
    if (IN(PH_GOUT)) {
        pg8::Gemm g{(const bf16*)a.out, (const bf16*)(ws + WS_WGOUT), M, DM, DM}; pg8::StaticOrder S; S.init(M, DM, G, blk);
        pg8::EpiRes<1> E{nullptr, XB, ST2, a.in[16], a.in[17], XB, ST3};
        GEMM_RUN(pg8::EpiRes<1>, g, S, E);
    } SEAM(PH_GOUT);
    if (IN(PH_UP1)) {
        pg8::Gemm g{XB, (const bf16*)(ws + WS_W1 + 8 * MiB), M, FF, DM}; pg8::StaticOrder S; S.init(M, FF, G, blk);
        pg8::EpiSqRelu E{HB, FF, pg8::LnFold{ST3, FOLD + 16384, FOLD + 20480}};
        GEMM_RUN(pg8::EpiSqRelu, g, S, E);
    } SEAM(PH_UP1);
    if (IN(PH_DN1)) {
        pg8::Gemm g{HB, (const bf16*)(ws + WS_W2 + 8 * MiB), M, DM, FF}; pg8::StaticOrder S; S.init(M, DM, G, blk);
        pg8::EpiRes<1> E{nullptr, XB, ST3, a.in[12] + DM, a.in[13] + DM, XB, (float*)(ws + WS_ST4)};
        GEMM_RUN(pg8::EpiRes<1>, g, S, E);
    } SEAM(PH_DN1);
    if (IN(PH_LN4)) { ln_final_pass(XB, (const float*)(ws + WS_ST4), a.in[16] + DM, a.in[17] + DM, a.out, gw, NGW, lane); }
#undef IN
#undef SEAM
#undef GEMM_RUN
}

#ifndef MK_MULTI
#define MK_MULTI 0
#endif
extern "C" void kernel_launch(void* const* d_in, const int* in_sizes, int n_in, void* d_out, int out_size, void* d_ws, size_t ws_size, hipStream_t stream) {
    static int grid = 0;
    if (grid == 0) {
        if (n_in != 18 || in_sizes[0] != M * DM || out_size != M * DM || ws_size < WS_END) { fprintf(stderr, "kernel_launch: unexpected shapes (n_in %d, in0 %d, out %d, ws %zu); nothing launched\n", n_in, n_in > 0 ? in_sizes[0] : -1, out_size, ws_size); grid = -1; return; }
        int dev = 0, cus = 0, per_cu = 0;
        hipGetDevice(&dev); hipDeviceGetAttribute(&cus, hipDeviceAttributeMultiprocessorCount, dev);
        if (hipFuncSetAttribute((const void*)fwd_kernel, hipFuncAttributeMaxDynamicSharedMemorySize, LDS_BYTES) != hipSuccess) { fprintf(stderr, "kernel_launch: hipFuncSetAttribute failed\n"); grid = -1; return; }
        hipOccupancyMaxActiveBlocksPerMultiprocessor(&per_cu, (const void*)fwd_kernel, NTHREADS, LDS_BYTES);
        if (per_cu < 1) { fprintf(stderr, "kernel_launch: occupancy query says %d blocks per CU\n", per_cu); per_cu = 1; }
        (void)hipGetLastError();
        grid = cus * 1;
        fprintf(stderr, "kernel_launch: cus %d per_cu %d grid %d\n", cus, per_cu, grid);
    }
    if (grid < 0) return;
    if (hipMemsetAsync((char*)d_ws + WS_CTL, 0, CTL_ZERO_BYTES, stream) != hipSuccess) { fprintf(stderr, "kernel_launch: memset failed\n"); return; }
    Args a{};
    for (int i = 0; i < 18; ++i) a.in[i] = (const float*)d_in[i];
    a.out = (float*)d_out; a.ws = (unsigned char*)d_ws;
#if MK_MULTI
    for (int ph = 0; ph < PH_COUNT; ++ph) { a.ph_lo = ph; a.ph_hi = ph + 1; hipLaunchKernelGGL(fwd_kernel, dim3(grid), dim3(NTHREADS), LDS_BYTES, stream, a); }
#else
    a.ph_lo = 0; a.ph_hi = PH_COUNT;
    void* args[] = {&a};
    hipError_t e = hipLaunchCooperativeKernel((const void*)fwd_kernel, dim3(grid), dim3(NTHREADS), args, LDS_BYTES, stream);
    if (e != hipSuccess) fprintf(stderr, "cooperative launch failed: %s (grid %d)\n", hipGetErrorString(e), grid);
#endif
}
```

```cpp
#include <hip/hip_runtime.h>
#include <hip/hip_cooperative_groups.h>
#include <cstdio>
#include <cstdint>
#include <cmath>
namespace cg = cooperative_groups;
namespace pg8 {
#define PG8_LAS __attribute__((address_space(3)))
typedef unsigned short bf16_t;
typedef short bf16x8 __attribute__((ext_vector_type(8)));
typedef float f32x4 __attribute__((ext_vector_type(4)));
typedef unsigned u32x4 __attribute__((ext_vector_type(4)));
constexpr int BM = 256, BK = 64, HALF = 128, HTB = HALF * BK * 2  , STAGE_BYTES = 8 * HTB, NXCD = 8, WGM = 8;

__host__ __device__ __forceinline__ int lds_byte(int r, int c) { const int st = (r >> 4) * 2 + (c >> 5), rr = r & 15, cc = c & 31, ob = rr * 64 + cc * 2; return st * 1024 + (ob ^ (((ob >> 9) & 1) << 5)); }
__host__ __device__ __forceinline__ void stage_rc(int b, int& R, int& C) { const int st = b / 1024, sb = b % 1024, swz = sb ^ (((sb >> 9) & 1) << 5); R = (st >> 1) * 16 + swz / 64; C = (st & 1) * 32 + (swz % 64) / 2; }
__host__ __device__ __forceinline__ int perm32(int rho) { const int n = rho >> 4, i = rho & 15; return 8 * (i >> 2) + 4 * n + (i & 3); }

struct Unit { int pm, pn; };
struct Gemm { const bf16_t* A; const bf16_t* Bt; int M, N, K; };

struct StaticOrder {
    int nM, nN, nwg, G, c;
    __host__ __device__ void init(int M, int N, int G_, int c_) { nM = M / BM; nN = N / BM; nwg = nM * nN; G = G_; c = c_; }
    __host__ __device__ bool next(int i, Unit& u) const {
        const long L = (long)i * G + c; if (L >= nwg) return false;
        int wgid = (int)L; { const int q = nwg / NXCD, r = nwg % NXCD, xcd = wgid % NXCD, off = wgid / NXCD; wgid = (xcd < r ? xcd * (q + 1) : r * (q + 1) + (xcd - r) * q) + off; }
        const int nig = WGM * nN, gid = wgid / nig, fm = gid * WGM, gsz = (nM - fm) < WGM ? (nM - fm) : WGM;
        u.pm = fm + ((wgid % nig) % gsz); u.pn = (wgid % nig) / gsz; return true;
    }
    __device__ __forceinline__ void a_ready(const Unit&) const {}
    __device__ __forceinline__ void done(const Unit&) const {}
};

__device__ __forceinline__ unsigned cvt_pk_bf16(float lo, float hi) { unsigned r; asm volatile("v_cvt_pk_bf16_f32 %0, %1, %2" : "=v"(r) : "v"(lo), "v"(hi)); return r; }
typedef float f32x2 __attribute__((ext_vector_type(2)));
typedef unsigned u32x2 __attribute__((ext_vector_type(2)));
__device__ __forceinline__ u32x4 pack8(f32x4 a, f32x4 b) { u32x4 w; w.x = cvt_pk_bf16(a[0], a[1]); w.y = cvt_pk_bf16(a[2], a[3]); w.z = cvt_pk_bf16(b[0], b[1]); w.w = cvt_pk_bf16(b[2], b[3]); return w; }

struct EpiQKV {
    static constexpr bool PERM = true, AFTER_DRAIN = false;
    bf16_t* Q; bf16_t* Kb; bf16_t* Vb; const float* cosT; const float* sinT; float qscale;
    __device__ __forceinline__ void operator()(const f32x4 (&acc)[2][2][4][2], const Unit& u, int wr, int wc, int fr, int fq) const {
        const int row0 = u.pm * BM + wr * 64 + fr; const int pn = u.pn;
        if (pn == 5) {
            const int col0 = wc * 32 + 8 * fq;
#pragma unroll
            for (int ai = 0; ai < 2; ++ai)
#pragma unroll
                for (int m = 0; m < 4; ++m) { bf16_t* rowp = Vb + (size_t)(row0 + ai * HALF + m * 16) * 256 + col0;
#pragma unroll
                    for (int bj = 0; bj < 2; ++bj) *(u32x4*)(rowp + bj * HALF) = pack8(acc[ai][bj][m][0], acc[ai][bj][m][1]); }
        } else {
            bf16_t* base; int ld, colt; float sc;
            if (pn < 4) { base = Q; ld = 1024; colt = pn * 256; sc = qscale; } else { base = Kb; ld = 256; colt = 0; sc = 1.f; }
            const int col0 = colt + wc * 32 + 8 * fq; const int d1 = 16 * (wc & 1) + 4 * fq;
            f32x4 cs[2][2], sn[2][2];
#define QKV_LOAD(bt, bf) do { _Pragma("unroll") for (int i_ = 0; i_ < 2; ++i_) { const int r8_ = 2 * (bt) + i_; const int row_ = row0 + (r8_ >> 2) * HALF + (r8_ & 3) * 16; \
                cs[bf][i_] = *(const f32x4*)(cosT + (size_t)row_ * 32 + d1); sn[bf][i_] = *(const f32x4*)(sinT + (size_t)row_ * 32 + d1); } } while (0)
            QKV_LOAD(0, 0);
#pragma unroll
            for (int bt = 0; bt < 4; ++bt) {
                if (bt + 1 < 4) { if ((bt + 1) & 1) QKV_LOAD(bt + 1, 1); else QKV_LOAD(bt + 1, 0); }
#pragma unroll
                for (int i = 0; i < 2; ++i) { const int r8 = 2 * bt + i, ai = r8 >> 2, m = r8 & 3; const int row = row0 + ai * HALF + m * 16;
                    const f32x4 c4 = cs[bt & 1][i], s4 = sn[bt & 1][i];
#pragma unroll
                    for (int bj = 0; bj < 2; ++bj) { const f32x4 t1 = acc[ai][bj][m][0], t2 = acc[ai][bj][m][1];
                        const f32x4 o1 = (t1 * c4 - t2 * s4) * sc, o2 = (t2 * c4 + t1 * s4) * sc;
                        *(u32x4*)(base + (size_t)row * ld + col0 + bj * HALF) = pack8(o1, o2); } }
            }
#undef QKV_LOAD
        }
    }
};
template <int MODE> struct EpiRes {
    static constexpr bool PERM = true, AFTER_DRAIN = false;
    const float* Rf; const bf16_t* Rb; const float* stats; const float* g; const float* b; bf16_t* ZB; float* STout;
    static constexpr float alpha = 1.41421356237309515f;
    __device__ __forceinline__ void operator()(const f32x4 (&acc)[2][2][4][2], const Unit& u, int wr, int wc, int fr, int fq) const {
        const int row0 = u.pm * BM + wr * 64 + fr, col0 = u.pn * BM + wc * 32 + 8 * fq;
        f32x4 rf[2][2][2]; u32x4 rbb[2][2]; f32x2 sb[2];
#define RES_LOAD(r8_, bf) do { const int row_ = row0 + ((r8_) >> 2) * HALF + ((r8_) & 3) * 16; const size_t off_ = (size_t)row_ * 1024 + col0; \
            if constexpr (MODE >= 1) { if constexpr (MODE == 1) sb[bf] = *(const f32x2*)(stats + 2 * (size_t)row_); rbb[bf][0] = *(const u32x4*)(Rb + off_); rbb[bf][1] = *(const u32x4*)(Rb + off_ + HALF); } \
            else { rf[bf][0][0] = *(const f32x4*)(Rf + off_); rf[bf][0][1] = *(const f32x4*)(Rf + off_ + 4); rf[bf][1][0] = *(const f32x4*)(Rf + off_ + HALF); rf[bf][1][1] = *(const f32x4*)(Rf + off_ + HALF + 4); } } while (0)
        RES_LOAD(0, 0);
        f32x4 gg[2][2], bb[2][2];
        if constexpr (MODE == 1) {
#pragma unroll
            for (int bj = 0; bj < 2; ++bj)
#pragma unroll
                for (int n = 0; n < 2; ++n) { gg[bj][n] = *(const f32x4*)(g + col0 + bj * HALF + 4 * n); bb[bj][n] = *(const f32x4*)(b + col0 + bj * HALF + 4 * n); }
        }
#pragma unroll
        for (int r8 = 0; r8 < 8; ++r8) {
            if (r8 + 1 < 8) RES_LOAD(r8 + 1, (r8 + 1) & 1);
            const int ai = r8 >> 2, m = r8 & 3; const int row = row0 + ai * HALF + m * 16; const size_t off = (size_t)row * 1024 + col0;
            float mean = 0.f, rstd = 1.f; if constexpr (MODE == 1) { const f32x2 st = sb[r8 & 1]; mean = st.x * (1.f / 1024.f); rstd = __builtin_amdgcn_rsqf(st.y * (1.f / 1024.f) - mean * mean + 1e-5f); }
            float s = 0.f, ss = 0.f;
#pragma unroll
            for (int bj = 0; bj < 2; ++bj) { f32x4 r0, r1;
                if constexpr (MODE >= 1) { const u32x4 w = rbb[r8 & 1][bj];
                    r0 = (f32x4){__builtin_bit_cast(float, w.x << 16), __builtin_bit_cast(float, w.x & 0xffff0000u), __builtin_bit_cast(float, w.y << 16), __builtin_bit_cast(float, w.y & 0xffff0000u)};
                    r1 = (f32x4){__builtin_bit_cast(float, w.z << 16), __builtin_bit_cast(float, w.z & 0xffff0000u), __builtin_bit_cast(float, w.w << 16), __builtin_bit_cast(float, w.w & 0xffff0000u)};
                    if constexpr (MODE == 1) { r0 = (r0 - mean) * rstd * gg[bj][0] + bb[bj][0]; r1 = (r1 - mean) * rstd * gg[bj][1] + bb[bj][1]; } }
                else { r0 = rf[r8 & 1][bj][0]; r1 = rf[r8 & 1][bj][1]; }
                const f32x4 o0 = r0 * alpha + acc[ai][bj][m][0], o1 = r1 * alpha + acc[ai][bj][m][1];
                *(u32x4*)(ZB + off + bj * HALF) = pack8(o0, o1);
                s += ((o0[0] + o0[1]) + (o0[2] + o0[3])) + ((o1[0] + o1[1]) + (o1[2] + o1[3]));
                ss += ((o0[0] * o0[0] + o0[1] * o0[1]) + (o0[2] * o0[2] + o0[3] * o0[3])) + ((o1[0] * o1[0] + o1[1] * o1[1]) + (o1[2] * o1[2] + o1[3] * o1[3])); }
            if (STout) { s += __shfl_xor(s, 16); s += __shfl_xor(s, 32); ss += __shfl_xor(ss, 16); ss += __shfl_xor(ss, 32);
                if (fq == 0) { __hip_atomic_fetch_add(STout + 2 * (size_t)row, s, __ATOMIC_RELAXED, __HIP_MEMORY_SCOPE_AGENT); __hip_atomic_fetch_add(STout + 2 * (size_t)row + 1, ss, __ATOMIC_RELAXED, __HIP_MEMORY_SCOPE_AGENT); } }
        }
#undef RES_LOAD
    }
};
struct LnFold { const float* st; const float* cs; const float* cb; };
__device__ __forceinline__ void ln_rows8(const float* st, int row0, float (&mean)[8], float (&rstd)[8]) {
    f32x2 v[8];
#pragma unroll
    for (int r8 = 0; r8 < 8; ++r8) v[r8] = *(const f32x2*)(st + 2 * (size_t)(row0 + (r8 >> 2) * HALF + (r8 & 3) * 16));
#pragma unroll
    for (int r8 = 0; r8 < 8; ++r8) { mean[r8] = v[r8].x * (1.f / 1024.f); rstd[r8] = __builtin_amdgcn_rsqf(v[r8].y * (1.f / 1024.f) - mean[r8] * mean[r8] + 1e-5f); }
}
struct EpiSqRelu {
    static constexpr bool PERM = true, AFTER_DRAIN = false;
    bf16_t* O; int ldc; LnFold f;
    __device__ __forceinline__ void operator()(const f32x4 (&acc)[2][2][4][2], const Unit& u, int wr, int wc, int fr, int fq) const {
        const int row0 = u.pm * BM + wr * 64, col0 = u.pn * BM + wc * 32 + 8 * fq; const f32x4 zero = {0.f, 0.f, 0.f, 0.f};
        f32x4 cs[2][2], cb[2][2];
#pragma unroll
        for (int bj = 0; bj < 2; ++bj)
#pragma unroll
            for (int n = 0; n < 2; ++n) { cs[bj][n] = *(const f32x4*)(f.cs + col0 + bj * HALF + 4 * n); cb[bj][n] = *(const f32x4*)(f.cb + col0 + bj * HALF + 4 * n); }
        float mean8[8], rstd8[8]; ln_rows8(f.st, row0 + fr, mean8, rstd8);
        const int hb = fr >> 3, r7 = fr & 7; const int pcol = u.pn * BM + 64 * wc + 32 * hb + 8 * fq;
#pragma unroll
        for (int ai = 0; ai < 2; ++ai)
#pragma unroll
            for (int m = 0; m < 4; ++m) { const float mean = mean8[ai * 4 + m], rstd = rstd8[ai * 4 + m];
                u32x4 d[2];
#pragma unroll
                for (int bj = 0; bj < 2; ++bj) {
                    f32x4 v0 = (acc[ai][bj][m][0] - cs[bj][0] * mean) * rstd + cb[bj][0], v1 = (acc[ai][bj][m][1] - cs[bj][1] * mean) * rstd + cb[bj][1];
                    v0 = __builtin_elementwise_max(v0, zero); v1 = __builtin_elementwise_max(v1, zero); d[bj] = pack8(v0 * v0, v1 * v1); }
                const u32x4 snd = hb ? d[0] : d[1]; u32x4 rcv;
                rcv.x = __shfl_xor(snd.x, 8); rcv.y = __shfl_xor(snd.y, 8); rcv.z = __shfl_xor(snd.z, 8); rcv.w = __shfl_xor(snd.w, 8);
                const int rbase = row0 + ai * HALF + m * 16;
                __builtin_nontemporal_store(hb ? rcv : d[0], (u32x4*)(O + (size_t)(rbase + r7) * ldc + pcol));
                __builtin_nontemporal_store(hb ? d[1] : rcv, (u32x4*)(O + (size_t)(rbase + 8 + r7) * ldc + pcol)); }
    }
};
struct EpiGin {
    static constexpr bool PERM = true, AFTER_DRAIN = false;
    bf16_t* Gq; bf16_t* Gk; bf16_t* Gv; bf16_t* Gr; float* LR; float qscale; LnFold f;
    __device__ __forceinline__ void operator()(const f32x4 (&acc)[2][2][4][2], const Unit& u, int wr, int wc, int fr, int fq) const {
        const int row0 = u.pm * BM + wr * 64 + fr; const int pn = u.pn; const int ccol0 = pn * BM + wc * 32 + 8 * fq;
        f32x4 cs[2][2], cb[2][2];
#pragma unroll
        for (int bj = 0; bj < 2; ++bj)
#pragma unroll
            for (int n = 0; n < 2; ++n) { cs[bj][n] = *(const f32x4*)(f.cs + ccol0 + bj * HALF + 4 * n); cb[bj][n] = *(const f32x4*)(f.cb + ccol0 + bj * HALF + 4 * n); }
        float mean8[8], rstd8[8]; ln_rows8(f.st, row0, mean8, rstd8);
        bf16_t* base; int ld, colt; float sc = 1.f;
        if (pn < 2) { base = Gq; ld = 512; colt = pn * 256; sc = qscale; } else if (pn < 4) { base = Gk; ld = 512; colt = (pn - 2) * 256; }
        else if (pn < 8) { base = Gv; ld = 1024; colt = (pn - 4) * 256; } else { base = Gr; ld = 1024; colt = (pn - 8) * 256; }
        const int col0 = colt + wc * 32 + 8 * fq;
#pragma unroll
        for (int ai = 0; ai < 2; ++ai)
#pragma unroll
            for (int m = 0; m < 4; ++m) { const int row = row0 + ai * HALF + m * 16; const float mean = mean8[ai * 4 + m], rstd = rstd8[ai * 4 + m];
#pragma unroll
                for (int bj = 0; bj < 2; ++bj) {
                    const f32x4 v0 = ((acc[ai][bj][m][0] - cs[bj][0] * mean) * rstd + cb[bj][0]) * sc, v1 = ((acc[ai][bj][m][1] - cs[bj][1] * mean) * rstd + cb[bj][1]) * sc;
                    if (pn == 12) { if (bj == 0 && wc == 0) { float* p = LR + (size_t)row * 32 + 8 * fq; *(f32x4*)p = v0; *(f32x4*)(p + 4) = v1; } }
                    else *(u32x4*)(base + (size_t)row * ld + col0 + bj * HALF) = pack8(v0, v1); } }
    }
};

template <class Epi, class Sched, bool ALIGN_EPI = false, bool SP2 = false>
__device__ __forceinline__ void gemm_phase(PG8_LAS unsigned char* lds, const Gemm g, const Sched& S, const Epi& E) {
    const int tid = threadIdx.x, wid = __builtin_amdgcn_readfirstlane(tid >> 6), lane = tid & 63, wr = wid >> 2, wc = wid & 3, fr = lane & 15, fq = lane >> 4;
    const int K = g.K, nt = K / BK;
    unsigned voffA[2], voffB[2];
#pragma unroll
    for (int i = 0; i < 2; ++i) { int R, C; stage_rc(tid * 16 + i * 8192, R, C); const int Rb = Epi::PERM ? ((R & ~31) + perm32(R & 31)) : R;
        voffA[i] = (unsigned)(R * K + C) * 2u; voffB[i] = (unsigned)(Rb * K + C) * 2u; }
    const size_t kstep = (size_t)(BK * 2);
    const size_t hstep = (size_t)HALF * K * 2;
    const size_t tstep = 2 * hstep;
    const unsigned ldsw = (unsigned)wid * 1024u;
    const int aoff = lds_byte(wr * 64 + fr, fq * 8), boff = lds_byte(wc * 32 + fr, fq * 8);
#define PG8_SA(b, h) (((b) * 2 + (h)) * HTB)
#define PG8_SB(b, h) ((4 + (b) * 2 + (h)) * HTB)
#define PG8_STAGE(bufoff, gbase, voff) do { _Pragma("unroll") for (int _i = 0; _i < 2; ++_i) \
        __builtin_amdgcn_global_load_lds((const unsigned*)((const char*)(gbase) + (voff)[_i]), (PG8_LAS unsigned*)(lds + (bufoff) + ldsw + _i * 8192), 16, 0, 0); } while (0)
#define PG8_LDA(dst, b, h) do { _Pragma("unroll") for (int m = 0; m < 4; ++m) _Pragma("unroll") for (int k = 0; k < 2; ++k) dst[m][k] = *(const PG8_LAS bf16x8*)(lds + PG8_SA(b, h) + aoff + m * 2048 + k * 1024); } while (0)
#define PG8_LDB(dst, b, h) do { _Pragma("unroll") for (int n = 0; n < 2; ++n) _Pragma("unroll") for (int k = 0; k < 2; ++k) dst[n][k] = *(const PG8_LAS bf16x8*)(lds + PG8_SB(b, h) + boff + n * 2048 + k * 1024); } while (0)
#define PG8_MMA(ai, bj, At, Bt) do { __builtin_amdgcn_s_setprio(1); _Pragma("unroll") for (int m = 0; m < 4; ++m) _Pragma("unroll") for (int n = 0; n < 2; ++n) _Pragma("unroll") for (int k = 0; k < 2; ++k) \
        acc[ai][bj][m][n] = __builtin_amdgcn_mfma_f32_16x16x32_bf16(Bt[n][k], At[m][k], acc[ai][bj][m][n], 0, 0, 0); __builtin_amdgcn_s_setprio(0); } while (0)
#define PG8_WAIT_V(n) asm volatile("s_waitcnt vmcnt(" #n ")" ::: "memory")
#define PG8_WAIT_L(n) asm volatile("s_waitcnt lgkmcnt(" #n ")" ::: "memory")
#define PG8_BAR __builtin_amdgcn_s_barrier()
#define PG8_SCHED __builtin_amdgcn_sched_barrier(0)
    Unit cur, nxt; int ui = 0;
    if (!S.next(0, cur)) return;
    f32x4 acc[2][2][4][2];
#pragma unroll
    for (int a = 0; a < 2; ++a)
#pragma unroll
        for (int b = 0; b < 2; ++b)
#pragma unroll
            for (int m = 0; m < 4; ++m)
#pragma unroll
                for (int n = 0; n < 2; ++n) acc[a][b][m][n] = (f32x4){0.f, 0.f, 0.f, 0.f};
    bf16x8 At[4][2], B0[2][2], B1[2][2];
    const char* cA = (const char*)g.A + (size_t)cur.pm * tstep; const char* cB = (const char*)g.Bt + (size_t)cur.pn * tstep;
    S.a_ready(cur);
    if constexpr (SP2) {
        PG8_STAGE(PG8_SB(0, 0), cB, voffB); PG8_STAGE(PG8_SB(0, 1), cB + hstep, voffB); PG8_STAGE(PG8_SA(0, 0), cA, voffA); PG8_STAGE(PG8_SA(0, 1), cA + hstep, voffA);
        if (wr == 1) PG8_BAR;
        PG8_WAIT_V(2); PG8_BAR;
        PG8_STAGE(PG8_SB(1, 0), cB + kstep, voffB); PG8_STAGE(PG8_SA(1, 0), cA + kstep, voffA); PG8_STAGE(PG8_SB(1, 1), cB + hstep + kstep, voffB);
        PG8_WAIT_V(6); PG8_BAR;
    } else {
        PG8_STAGE(PG8_SB(0, 0), cB, voffB); PG8_STAGE(PG8_SA(0, 0), cA, voffA); PG8_STAGE(PG8_SB(0, 1), cB + hstep, voffB); PG8_STAGE(PG8_SA(0, 1), cA + hstep, voffA);
        if (wr == 1) PG8_BAR;
        PG8_WAIT_V(4); PG8_BAR;
        PG8_STAGE(PG8_SB(1, 0), cB + kstep, voffB); PG8_STAGE(PG8_SA(1, 0), cA + kstep, voffA); PG8_STAGE(PG8_SB(1, 1), cB + hstep + kstep, voffB);
        PG8_WAIT_V(6); PG8_BAR;
    }
    for (;;) {
        const bool has_next = S.next(ui + 1, nxt);
        const char* nA = has_next ? (const char*)g.A + (size_t)nxt.pm * tstep : cA; const char* nB = has_next ? (const char*)g.Bt + (size_t)nxt.pn * tstep : cB;
        for (int t = 0; t < nt; t += 2) {
            const bool last = (t == nt - 2);
            const char* a1 = cA + (size_t)(t + 1) * kstep;
            const char* a2 = last ? nA : cA + (size_t)(t + 2) * kstep; const char* b2 = last ? nB : cB + (size_t)(t + 2) * kstep;
            const char* a3 = a2 + kstep; const char* b3 = b2 + kstep;
            if (last && has_next) S.a_ready(nxt);
            if constexpr (SP2) {
            PG8_LDB(B0, 0, 0); PG8_LDB(B1, 0, 1); PG8_SCHED; PG8_LDA(At, 0, 0); PG8_STAGE(PG8_SA(1, 1), a1 + hstep, voffA);
            PG8_WAIT_V(8); PG8_WAIT_L(0); PG8_BAR; PG8_MMA(0, 0, At, B0); PG8_MMA(0, 1, At, B1); PG8_BAR; PG8_SCHED;
            PG8_LDA(At, 0, 1); PG8_STAGE(PG8_SB(0, 0), b2, voffB); PG8_STAGE(PG8_SB(0, 1), b2 + hstep, voffB); PG8_STAGE(PG8_SA(0, 0), a2, voffA);
            PG8_WAIT_V(8); PG8_WAIT_L(0); PG8_BAR; PG8_MMA(1, 0, At, B0); PG8_MMA(1, 1, At, B1); PG8_BAR; PG8_SCHED;
            PG8_LDB(B0, 1, 0); PG8_LDB(B1, 1, 1); PG8_SCHED; PG8_LDA(At, 1, 0); PG8_STAGE(PG8_SA(0, 1), a2 + hstep, voffA);
            PG8_WAIT_V(8); PG8_WAIT_L(0); PG8_BAR; PG8_MMA(0, 0, At, B0); PG8_MMA(0, 1, At, B1); PG8_BAR; PG8_SCHED;
            PG8_LDA(At, 1, 1); PG8_STAGE(PG8_SB(1, 0), b3, voffB); PG8_STAGE(PG8_SB(1, 1), b3 + hstep, voffB); PG8_STAGE(PG8_SA(1, 0), a3, voffA);
            PG8_WAIT_V(8); PG8_WAIT_L(0); PG8_BAR; PG8_MMA(1, 0, At, B0); PG8_MMA(1, 1, At, B1); PG8_BAR; PG8_SCHED;
            } else {
            PG8_LDB(B0, 0, 0); PG8_SCHED; PG8_LDA(At, 0, 0); PG8_STAGE(PG8_SA(1, 1), a1 + hstep, voffA);
            PG8_WAIT_L(8); PG8_BAR; PG8_WAIT_L(0); PG8_MMA(0, 0, At, B0); PG8_BAR; PG8_SCHED;
            PG8_LDB(B1, 0, 1); PG8_STAGE(PG8_SB(0, 0), b2, voffB);
            PG8_BAR; PG8_WAIT_L(0); PG8_MMA(0, 1, At, B1); PG8_BAR;
            PG8_LDA(At, 0, 1); PG8_STAGE(PG8_SA(0, 0), a2, voffA);
            PG8_BAR; PG8_WAIT_L(0); PG8_MMA(1, 0, At, B0); PG8_BAR; PG8_SCHED;
            PG8_STAGE(PG8_SB(0, 1), b2 + hstep, voffB);
            PG8_WAIT_V(6); PG8_BAR; PG8_MMA(1, 1, At, B1); PG8_BAR;
            PG8_LDB(B0, 1, 0); PG8_SCHED; PG8_LDA(At, 1, 0); PG8_STAGE(PG8_SA(0, 1), a2 + hstep, voffA);
            PG8_WAIT_L(8); PG8_BAR; PG8_WAIT_L(0); PG8_MMA(0, 0, At, B0); PG8_BAR; PG8_SCHED;
            PG8_LDB(B1, 1, 1); PG8_STAGE(PG8_SB(1, 0), b3, voffB);
            PG8_BAR; PG8_WAIT_L(0); PG8_MMA(0, 1, At, B1); PG8_BAR;
            PG8_LDA(At, 1, 1); PG8_STAGE(PG8_SA(1, 0), a3, voffA);
            PG8_BAR; PG8_WAIT_L(0); PG8_MMA(1, 0, At, B0); PG8_BAR; PG8_SCHED;
            PG8_STAGE(PG8_SB(1, 1), b3 + hstep, voffB);
            PG8_WAIT_V(6); PG8_BAR; PG8_MMA(1, 1, At, B1); PG8_BAR;
            }
        }
        if constexpr (ALIGN_EPI) { if (wr == 0) PG8_BAR; }
        if constexpr (!Epi::AFTER_DRAIN) { E(acc, cur, wr, wc, fr, fq); S.done(cur); }
        if (!has_next) break;
#pragma unroll
        for (int a = 0; a < 2; ++a)
#pragma unroll
            for (int b = 0; b < 2; ++b)
#pragma unroll
                for (int m = 0; m < 4; ++m)
#pragma unroll
                    for (int n = 0; n < 2; ++n) acc[a][b][m][n] = (f32x4){0.f, 0.f, 0.f, 0.f};
        cur = nxt; cA = nA; cB = nB; ++ui;
        if constexpr (ALIGN_EPI) { if (wr == 1) PG8_BAR; }
    }
    PG8_WAIT_V(0);
    if constexpr (!ALIGN_EPI) { if (wr == 0) PG8_BAR; }
    PG8_BAR;
    if constexpr (Epi::AFTER_DRAIN) { E.fused(acc, cur, wr, wc, fr, fq, lds, wid, lane); S.done(cur); }
#undef PG8_SA
#undef PG8_SB
#undef PG8_STAGE
#undef PG8_LDA
#undef PG8_LDB
#undef PG8_MMA
#undef PG8_WAIT_V
#undef PG8_WAIT_L
#undef PG8_BAR
#undef PG8_SCHED
}
}

#ifndef PG8_SP2
#define PG8_SP2 true
#endif
#ifndef PG8_ALIGN
#define PG8_ALIGN true
#endif
constexpr int NB = 8, SEQ = 8192, DM = 1024, FF = 4096, M = NB * SEQ;
constexpr int AH = 16, AKV = 4, AHD = 64, A_IN = 1536;
constexpr int GH = 4, GDK = 128, GDV = 256, G_IN = 3104, G_INP = 3328, GQK = 512, GVC = 1024;
constexpr float LN_EPS = 1e-5f, HN_EPS = 1e-6f;
constexpr float DN_ALPHA = 1.41421356237309515f;
constexpr float LOG2E = 1.4426950408889634f;
constexpr int NWAVES = 8, NTHREADS = 512;
constexpr size_t MiB = 1u << 20;
constexpr size_t WS_CTL = 0, CTL_ZERO_BYTES = 2 * MiB;
constexpr size_t WS_FOLD = 32 * 1024;
constexpr size_t WS_ST4 = 13 * MiB + 512 * 1024;
constexpr size_t WS_ST1 = 512 * 1024, WS_ST2 = 1024 * 1024, WS_ST3 = 1536 * 1024;
constexpr size_t WS_WAIN = 2 * MiB, WS_WAOUT = 5 * MiB, WS_WGIN = 7 * MiB, WS_WGOUT = 14 * MiB, WS_W1 = 16 * MiB, WS_W2 = 32 * MiB;
constexpr size_t WS_COS = 48 * MiB, WS_SIN = 56 * MiB;
constexpr size_t WS_LR = 48 * MiB, WS_DL = 56 * MiB;
constexpr size_t WS_ATT = 64 * MiB;
constexpr size_t WS_XB = 128 * MiB;
constexpr size_t WS_R = 512 * MiB;
constexpr size_t WS_Q = WS_R, WS_K = WS_R + 128 * MiB, WS_V = WS_R + 160 * MiB, WS_O = WS_R + 192 * MiB;
constexpr size_t WS_GQ = WS_R, WS_GK = WS_R + 64 * MiB, WS_GV = WS_R + 128 * MiB, WS_GR = WS_R + 256 * MiB, WS_QEB = WS_R + 384 * MiB, WS_KDB = WS_R + 448 * MiB;
constexpr size_t WS_END = 1024 * MiB;
constexpr int MISC_OFF = 147456;
constexpr int LDS_BYTES = 147456 + 256;

#define GAS __attribute__((address_space(1)))
#define LAS __attribute__((address_space(3)))
typedef unsigned short bf16;
typedef unsigned v4u __attribute__((ext_vector_type(4)));
typedef unsigned v2u __attribute__((ext_vector_type(2)));
typedef float f32x4 __attribute__((ext_vector_type(4)));
typedef float f32x2 __attribute__((ext_vector_type(2)));
typedef short bf16x8 __attribute__((ext_vector_type(8)));
#define DI __device__ __forceinline__
DI unsigned f2bf(float f) { unsigned u = __builtin_bit_cast(unsigned, f); return (u + 0x7fffu + ((u >> 16) & 1u)) >> 16; }
DI unsigned pk2(float lo, float hi) { return f2bf(lo) | (f2bf(hi) << 16); }
DI float bf2f(unsigned short h) { return __builtin_bit_cast(float, (unsigned)h << 16); }
DI float bflo(unsigned w) { return __builtin_bit_cast(float, w << 16); }
DI float bfhi(unsigned w) { return __builtin_bit_cast(float, w & 0xffff0000u); }
DI float wave_sum(float v) {
#pragma unroll
    for (int o = 1; o < 64; o <<= 1) v += __shfl_xor(v, o);
    return v;
}

DI int rope_dest(int c) { const int hh = c >> 6, dd = c & 63, n = dd >> 5, d1 = dd & 31; return (hh << 6) + 8 * (d1 >> 2) + 4 * n + (d1 & 3); }
DI int hid_perm(int c) { return (c & ~255) + 64 * ((c >> 5) & 3) + 32 * ((c >> 7) & 1) + (c & 31); }
DI void p0_transpose_item(const float* W, int K, int N, bf16* WT, int rope_cols, LAS float* scr, int item, int lane, const float* gv = nullptr, const float* bv = nullptr, float* cs = nullptr, float* cb = nullptr, bool hperm = false) {
    const int nblk = N / 32, kb = item / nblk, nb = item % nblk, k0 = 64 * kb, n0 = 32 * nb;
    float csp = 0.f, cbp = 0.f;
#pragma unroll 8
    for (int i = 0; i < 32; ++i) { const int kk = 2 * i + (lane >> 5); float w = W[(size_t)(k0 + kk) * N + n0 + (lane & 31)];
        if (gv) { cbp += bv[k0 + kk] * w; w *= gv[k0 + kk]; csp += __builtin_bit_cast(float, f2bf(w) << 16); }
        scr[kk * 33 + (lane & 31)] = w; }
    if (gv) { __hip_atomic_fetch_add(cs + n0 + (lane & 31), csp, __ATOMIC_RELAXED, __HIP_MEMORY_SCOPE_AGENT); __hip_atomic_fetch_add(cb + n0 + (lane & 31), cbp, __ATOMIC_RELAXED, __HIP_MEMORY_SCOPE_AGENT); }
    asm volatile("s_waitcnt lgkmcnt(0)" ::: "memory");
    const int c = lane & 7;
#pragma unroll
    for (int j = 0; j < 4; ++j) { const int n = (lane >> 3) + 8 * j; const LAS float* s = scr + (8 * c) * 33 + n;
        v4u o; o.x = pk2(s[0 * 33], s[1 * 33]); o.y = pk2(s[2 * 33], s[3 * 33]); o.z = pk2(s[4 * 33], s[5 * 33]); o.w = pk2(s[6 * 33], s[7 * 33]);
        const int col = n0 + n; const int drow = col < rope_cols ? rope_dest(col) : col;
        const int kd = hperm ? hid_perm(k0 + 8 * c) : k0 + 8 * c;
        *(v4u*)(WT + (size_t)drow * K + kd) = o; }
    asm volatile("s_waitcnt lgkmcnt(0)" ::: "memory");
}
struct Args { const float* in[18]; float* out; unsigned char* ws; int ph_lo, ph_hi; };

DI void p0_prologue(const Args& a, LAS unsigned char* lds, int gw, int NGW, int wave, int lane) {
    LAS float* scr = (LAS float*)(lds + wave * 16384);
    unsigned char* ws = a.ws;
    constexpr int I_AIN = (DM / 64) * (A_IN / 32), I_SQ = (DM / 64) * (DM / 32), I_GIN = (DM / 64) * (G_IN / 32), I_1 = (DM / 64) * (FF / 32), I_2 = (FF / 64) * (DM / 32);
    constexpr int NITEMS = I_AIN + 2 * I_SQ + I_GIN + 2 * I_1 + 2 * I_2;
    for (int it = gw; it < NITEMS; it += NGW) {
        int r = it;
        if (r < I_AIN) { p0_transpose_item(a.in[2], DM, A_IN, (bf16*)(ws + WS_WAIN), 1280, scr, r, lane); continue; } r -= I_AIN;
        if (r < I_SQ) { p0_transpose_item(a.in[4], DM, DM, (bf16*)(ws + WS_WAOUT), 0, scr, r, lane); continue; } r -= I_SQ;
        if (r < I_GIN) { p0_transpose_item(a.in[5], DM, G_IN, (bf16*)(ws + WS_WGIN), 0, scr, r, lane, a.in[16], a.in[17], (float*)(ws + WS_FOLD + 32768), (float*)(ws + WS_FOLD + 49152)); continue; } r -= I_GIN;
        if (r < I_SQ) { p0_transpose_item(a.in[11], DM, DM, (bf16*)(ws + WS_WGOUT), 0, scr, r, lane); continue; } r -= I_SQ;
        if (r < 2 * I_1) { const int l = r / I_1; p0_transpose_item(a.in[14] + (size_t)l * DM * FF, DM, FF, (bf16*)(ws + WS_W1 + l * 8 * MiB), 0, scr, r % I_1, lane, a.in[12] + l * DM, a.in[13] + l * DM, (float*)(ws + WS_FOLD + (l ? 65536 : 0)), (float*)(ws + WS_FOLD + (l ? 81920 : 16384))); continue; } r -= 2 * I_1;
        { const int l = r / I_2; p0_transpose_item(a.in[15] + (size_t)l * DM * FF, FF, DM, (bf16*)(ws + WS_W2 + l * 8 * MiB), 0, scr, r % I_2, lane, nullptr, nullptr, nullptr, nullptr, true); }
    }
    { v4u* z = (v4u*)(ws + WS_WGIN + (size_t)G_IN * DM * 2); const int n16 = (G_INP - G_IN) * DM * 2 / 16;
      for (int i = gw * 64 + lane; i < n16; i += NGW * 64) z[i] = (v4u){0u, 0u, 0u, 0u}; }
    { const f32x4* x4 = (const f32x4*)a.in[0]; v2u* o = (v2u*)(ws + WS_XB); const int n4 = M * DM / 4, step = NGW * 64;
      for (int i = gw * 64 + lane; i < n4; i += 8 * step) { f32x4 v[8];
#pragma unroll
          for (int k = 0; k < 8; ++k) v[k] = x4[(i + k * step < n4) ? i + k * step : i];
#pragma unroll
          for (int k = 0; k < 8; ++k) if (i + k * step < n4) o[i + k * step] = (v2u){pk2(v[k].x, v[k].y), pk2(v[k].z, v[k].w)}; } }
    { f32x4* z4 = (f32x4*)(ws + WS_ST4); for (int i = gw * 64 + lane; i < M * 2 / 4; i += NGW * 64) z4[i] = (f32x4){0.f, 0.f, 0.f, 0.f}; }
    { const int* pos = (const int*)a.in[1]; float* ct = (float*)(ws + WS_COS); float* st = (float*)(ws + WS_SIN);
      for (int i = gw * 64 + lane; i < M * 32; i += NGW * 64) { const int row = i >> 5, f = i & 31;
          const float inv = (float)exp(-(double)f * (9.210340371976184 / 32.0));
          const float ang = (float)pos[row] * inv;
          const double ad = (double)ang; const double k = rint(ad * 0.15915494309189535); const float r = (float)(ad - k * 6.283185307179586);
          ct[i] = cosf(r); st[i] = sinf(r); } }
}

DI void ln_final_pass(const bf16* ZB, const float* ST, const float* g, const float* b, float* out, int gw, int NGW, int lane) {
    f32x4 gv[2][2], bv[2][2];
#pragma unroll
    for (int j = 0; j < 2; ++j)
#pragma unroll
        for (int n = 0; n < 2; ++n) { gv[j][n] = *(const f32x4*)(g + 8 * lane + 512 * j + 4 * n); bv[j][n] = *(const f32x4*)(b + 8 * lane + 512 * j + 4 * n); }
    for (int m = 4 * gw; m < M; m += 4 * NGW) {
        v4u v[4][2]; f32x2 st[4];
#pragma unroll
        for (int r = 0; r < 4; ++r) { st[r] = *(const f32x2*)(ST + 2 * (size_t)(m + r));
#pragma unroll
            for (int j = 0; j < 2; ++j) v[r][j] = *(const v4u*)(ZB + (size_t)(m + r) * DM + 8 * lane + 512 * j); }
#pragma unroll
        for (int r = 0; r < 4; ++r) { const float mean = st[r].x * (1.f / DM), rstd = __builtin_amdgcn_rsqf(st[r].y * (1.f / DM) - mean * mean + LN_EPS);
#pragma unroll
            for (int j = 0; j < 2; ++j) { const v4u w = v[r][j];
                const f32x4 x0 = {bflo(w.x), bfhi(w.x), bflo(w.y), bfhi(w.y)}, x1 = {bflo(w.z), bfhi(w.z), bflo(w.w), bfhi(w.w)};
                float* o = out + (size_t)(m + r) * DM + 8 * lane + 512 * j;
                *(f32x4*)o = (x0 - mean) * rstd * gv[j][0] + bv[j][0]; *(f32x4*)(o + 4) = (x1 - mean) * rstd * gv[j][1] + bv[j][1]; } }
    }
}

DI void gla_norm_pass(const bf16* OF, const bf16* OB, const bf16* Gr, const float* ng, bf16* Y, int gw, int NGW, int lane) {
    float g16[16];
#pragma unroll
    for (int i = 0; i < 16; ++i) g16[i] = ng[(lane & 15) * 16 + i];
    v4u a0, a1, b0, b1, r0, r1;
#define GN_LOAD(m_) do { const size_t off_ = (size_t)(m_) * GVC + lane * 16; a0 = *(const v4u*)(OF + off_); a1 = *(const v4u*)(OF + off_ + 8); b0 = *(const v4u*)(OB + off_); b1 = *(const v4u*)(OB + off_ + 8); r0 = *(const v4u*)(Gr + off_); r1 = *(const v4u*)(Gr + off_ + 8); } while (0)
    if (gw < M) GN_LOAD(gw);
    for (int m = gw; m < M; m += NGW) {
        const size_t off = (size_t)m * GVC + lane * 16;
        float o[16], r[16];
        const unsigned aw[8] = {a0.x, a0.y, a0.z, a0.w, a1.x, a1.y, a1.z, a1.w}, bw[8] = {b0.x, b0.y, b0.z, b0.w, b1.x, b1.y, b1.z, b1.w}, rw[8] = {r0.x, r0.y, r0.z, r0.w, r1.x, r1.y, r1.z, r1.w};
        { const int mn = (m + NGW < M) ? m + NGW : m; GN_LOAD(mn); }
        float ss = 0.f;
#pragma unroll
        for (int i = 0; i < 8; ++i) { o[2 * i] = bflo(aw[i]) + bflo(bw[i]); o[2 * i + 1] = bfhi(aw[i]) + bfhi(bw[i]); r[2 * i] = bflo(rw[i]); r[2 * i + 1] = bfhi(rw[i]); ss += o[2 * i] * o[2 * i] + o[2 * i + 1] * o[2 * i + 1]; }
        ss += __shfl_xor(ss, 1); ss += __shfl_xor(ss, 2); ss += __shfl_xor(ss, 4); ss += __shfl_xor(ss, 8);
        const float rs = __builtin_amdgcn_rsqf(ss * (1.f / GDV) + HN_EPS);
        unsigned w[8];
#pragma unroll
        for (int i = 0; i < 8; ++i) { const float x0 = o[2 * i] * rs * g16[2 * i], x1 = o[2 * i + 1] * rs * g16[2 * i + 1];
            const float s0 = r[2 * i] * __builtin_amdgcn_rcpf(1.f + __builtin_amdgcn_exp2f(-r[2 * i] * LOG2E)), s1 = r[2 * i + 1] * __builtin_amdgcn_rcpf(1.f + __builtin_amdgcn_exp2f(-r[2 * i + 1] * LOG2E)); w[i] = pk2(x0 * s0, x1 * s1); }
        *(v4u*)(Y + off) = (v4u){w[0], w[1], w[2], w[3]}; *(v4u*)(Y + off + 8) = (v4u){w[4], w[5], w[6], w[7]};
    }
#undef GN_LOAD
}

#define XB_TMO      128
#define XB_XCNT(j)  (256  + 64 * (j))
#define XB_XSUB(j)  (1280 + 64 * (j))
#define XB_XGEN(j)  (2304 + 64 * (j))
#define XB_TOP      3328
#define XB_TOPGEN   3392
#define XCD_BAR_WORDS 3456
#define XB_SPIN_CAP (1u << 18)

__device__ __forceinline__ unsigned xb_ld(unsigned* p)              { return __hip_atomic_load(p, __ATOMIC_RELAXED, __HIP_MEMORY_SCOPE_AGENT); }
__device__ __forceinline__ unsigned xb_add(unsigned* p, unsigned v) { return __hip_atomic_fetch_add(p, v, __ATOMIC_RELAXED, __HIP_MEMORY_SCOPE_AGENT); }
__device__ __forceinline__ unsigned xb_xcc_id() { return (unsigned)__builtin_amdgcn_s_getreg((3 << 11) | 20) & 0xFu; }
#define XB_SPIN(cond, bar) do { unsigned _sp = 0; while (cond) { __builtin_amdgcn_s_sleep(1); \
    if ((++_sp & 255u) == 0u) { if (xb_ld(&(bar)[XB_TMO])) break; if (_sp > XB_SPIN_CAP) { atomicAdd(&(bar)[XB_TMO], 1u); break; } } } } while (0)

struct XcdBarrier {
    unsigned* bar; unsigned x;
    volatile LAS unsigned* st;
};

__device__ __forceinline__ XcdBarrier xcd_barrier_post(unsigned* bar, volatile LAS unsigned* st) {
    XcdBarrier b; b.bar = bar; b.x = xb_xcc_id(); b.st = st;
    if (threadIdx.x == 0) (void)xb_add(&bar[XB_XCNT(b.x)], 1u);
    return b;
}
__device__ __forceinline__ void xcd_barrier_complete(unsigned* bar, unsigned x, unsigned& nloc, unsigned& nx) {
    const unsigned G = gridDim.x * gridDim.y * gridDim.z;
    unsigned sum, cnt, mine, sp = 0u;
    for (;;) {
        sum = 0u; cnt = 0u; mine = 0u;
#pragma unroll
        for (unsigned j = 0; j < 16; ++j) { const unsigned c = xb_ld(&bar[XB_XCNT(j)]); sum += c; cnt += (c > 0u) ? 1u : 0u; mine = (j == x) ? c : mine; }
        if (sum == G) break;
        __builtin_amdgcn_s_sleep(1);
        if ((++sp & 255u) == 0u) { if (xb_ld(&bar[XB_TMO])) break; if (sp > XB_SPIN_CAP) { atomicAdd(&bar[XB_TMO], 1u); break; } }
    }
    nloc = mine > 0u ? mine : 1u; nx = cnt > 0u ? cnt : 1u;
}

__device__ __forceinline__ void xcd_barrier(const XcdBarrier& b) {
    asm volatile("s_waitcnt vmcnt(0)" ::: "memory");
    __syncthreads();
    if (threadIdx.x == 0) {
        unsigned* bar = b.bar;
        __builtin_amdgcn_s_waitcnt(0);
        unsigned nloc = b.st[0], nx = b.st[1];
        if (nloc == 0u) { xcd_barrier_complete(bar, b.x, nloc, nx); b.st[0] = nloc; b.st[1] = nx; }
        const unsigned old = xb_add(&bar[XB_XSUB(b.x)], 1u);
        const unsigned gen = old / nloc;
        if (old + 1u == (gen + 1u) * nloc) {
            __builtin_amdgcn_fence(__ATOMIC_RELEASE, "agent");
            asm volatile("s_waitcnt vmcnt(0)" ::: "memory");
            const unsigned og = xb_add(&bar[XB_TOP], 1u);
            const unsigned tg = og / nx;
            if (og + 1u == (tg + 1u) * nx) xb_add(&bar[XB_TOPGEN], 1u);
            else XB_SPIN(xb_ld(&bar[XB_TOPGEN]) == tg, bar);
            __builtin_amdgcn_fence(__ATOMIC_ACQUIRE, "agent");
            xb_add(&bar[XB_XGEN(b.x)], 1u);
            asm volatile("s_waitcnt vmcnt(0)" ::: "memory");
        } else {
            XB_SPIN(xb_ld(&bar[XB_XGEN(b.x)]) == gen, bar);
            __builtin_amdgcn_fence(__ATOMIC_ACQUIRE, "agent");
            asm volatile("s_waitcnt vmcnt(0)" ::: "memory");
        }
    }
    __syncthreads();
}
typedef float f32x16 __attribute__((ext_vector_type(16)));
typedef short s16x4 __attribute__((ext_vector_type(4)));
typedef __bf16 bf16x2_t __attribute__((ext_vector_type(2)));
DI unsigned cvtpk(float lo, float hi) { f32x2 v = {lo, hi}; bf16x2_t b = __builtin_convertvector(v, bf16x2_t); return __builtin_bit_cast(unsigned, b); }
DI s16x4 tr_read(const LAS unsigned char* p) { return __builtin_bit_cast(s16x4, __builtin_amdgcn_ds_read_tr16_b64_v4i16((LAS s16x4*)p)); }
DI int crow(int reg, int h) { return (reg & 3) + 8 * (reg >> 2) + 4 * h; }
DI bf16x8 pack_step(const f32x16& x, int s) { v4u p; p.x = cvtpk(x[8 * s], x[8 * s + 1]); p.y = cvtpk(x[8 * s + 2], x[8 * s + 3]); p.z = cvtpk(x[8 * s + 4], x[8 * s + 5]); p.w = cvtpk(x[8 * s + 6], x[8 * s + 7]); return __builtin_bit_cast(bf16x8, p); }
#define MFMA32(a, b, c) __builtin_amdgcn_mfma_f32_32x32x16_bf16((a), (b), (c), 0, 0, 0)
#define MFMA16(a, b, c) __builtin_amdgcn_mfma_f32_16x16x32_bf16((a), (b), (c), 0, 0, 0)
constexpr int ATT_KP = 144, ATT_VP = 144, ATT_V_OFF = 512 * ATT_KP;
static_assert(ATT_V_OFF + 512 * ATT_VP <= 147456, "attention LDS");

DI void attn_mfma(const bf16* Q, const bf16* Kb, const bf16* Vb, bf16* O, const float* sink, LAS unsigned char* lds, int blk, int G, int tid) {
    const int lane = tid & 63, wave = __builtin_amdgcn_readfirstlane(tid >> 6), r32 = lane & 31, h = lane >> 5, i16 = lane & 15, blk16 = (lane >> 4) & 1;
    const int hl = wave >> 1, qloc = (wave & 1) * 64;
    const int vblk = (G % 8 == 0) ? (blk % 8) * (G / 8) + blk / 8 : blk;
    for (int run = vblk; run < NB * AKV * 8; run += G) {
        const int b = run >> 5, kvh = (run >> 3) & 3, qb0 = (run & 7) * 8;
        const int head = kvh * 4 + hl;
        const bf16* Kg = Kb + (size_t)b * SEQ * 256 + kvh * 64; const bf16* Vg = Vb + (size_t)b * SEQ * 256 + kvh * 64;
        __syncthreads();
#pragma unroll
        for (int i = 0; i < 6; ++i) { const int c = tid + 512 * i, r = c >> 3, ch = c & 7, kpos = 128 * (qb0 - 1) + r;
            v4u kv = {0u, 0u, 0u, 0u}, vv = {0u, 0u, 0u, 0u};
            if (kpos >= 0 && kpos < SEQ) { kv = *(const v4u*)(Kg + (size_t)kpos * 256 + ch * 8); vv = *(const v4u*)(Vg + (size_t)kpos * 256 + ch * 8); }
            *(LAS v4u*)(lds + (kpos & 511) * ATT_KP + ch * 16) = kv; *(LAS v4u*)(lds + ATT_V_OFF + (kpos & 511) * ATT_VP + ch * 16) = vv; }
        bf16x8 qf[2][4];
        { const size_t qrow0 = (size_t)b * SEQ + qb0 * 128 + qloc;
#pragma unroll
          for (int q2 = 0; q2 < 2; ++q2)
#pragma unroll
              for (int ks = 0; ks < 4; ++ks) qf[q2][ks] = *(const bf16x8*)(Q + (qrow0 + 32 * q2 + r32) * 1024 + head * 64 + 16 * ks + 8 * h); }
        const float m0 = sink[head] * LOG2E;
        __syncthreads();
        for (int j = 0; j < 8; ++j) {
            const int qb = qb0 + j; const int qp0 = qb * 128 + qloc; const size_t qrow0 = (size_t)b * SEQ + qp0;
            v4u pk[2], pv[2]; bf16x8 qn[2][4];
            const int nk0 = 128 * (qb + 2); const bool pf = (j < 7) && (nk0 < SEQ);
#pragma unroll
            for (int i = 0; i < 2; ++i) { const int c = tid + 512 * i, r = c >> 3, ch = c & 7; const int kpos = pf ? nk0 + r : 0;
                pk[i] = *(const v4u*)(Kg + (size_t)kpos * 256 + ch * 8); pv[i] = *(const v4u*)(Vg + (size_t)kpos * 256 + ch * 8); }
            { const size_t qrn = (j < 7) ? qrow0 + 128 : qrow0;
#pragma unroll
              for (int q2 = 0; q2 < 2; ++q2)
#pragma unroll
                  for (int ks = 0; ks < 4; ++ks) qn[q2][ks] = *(const bf16x8*)(Q + (qrn + 32 * q2 + r32) * 1024 + head * 64 + 16 * ks + 8 * h); }
            f32x16 oT[2][2];
#pragma unroll
            for (int a = 0; a < 2; ++a)
#pragma unroll
                for (int c = 0; c < 2; ++c)
#pragma unroll
                    for (int i = 0; i < 16; ++i) oT[a][c][i] = 0.f;
            float mrun[2] = {m0, m0}; float lrun[2]; lrun[0] = lrun[1] = (h == 0) ? 1.f : 0.f;
            for (int kt = 0; kt < 10; ++kt) {
                const int kp0 = qp0 - 128 + 32 * kt, kr0 = kp0 & 511;
                bf16x8 kf[4];
#pragma unroll
                for (int ks = 0; ks < 4; ++ks) kf[ks] = *(const LAS bf16x8*)(lds + (kr0 + r32) * ATT_KP + (16 * ks + 8 * h) * 2);
                f32x16 sT[2];
#pragma unroll
                for (int q2 = 0; q2 < 2; ++q2) {
#pragma unroll
                    for (int i = 0; i < 16; ++i) sT[q2][i] = 0.f;
#pragma unroll
                    for (int ks = 0; ks < 4; ++ks) sT[q2] = MFMA32(kf[ks], qf[q2][ks], sT[q2]);
                }
                const bool full = (kp0 >= 0) && (kp0 + 31 < SEQ) && (qp0 + 63 - kp0 <= 128) && (kp0 + 31 - qp0 <= 128);
                if (!full) {
#pragma unroll
                    for (int q2 = 0; q2 < 2; ++q2) { const int qpos = qp0 + 32 * q2 + r32;
#pragma unroll
                        for (int i = 0; i < 16; ++i) { const int kpos = kp0 + crow(i, h), dl = qpos - kpos; if (kpos < 0 || kpos >= SEQ || dl > 128 || dl < -128) sT[q2][i] = -INFINITY; } }
                }
#pragma unroll
                for (int q2 = 0; q2 < 2; ++q2) {
                    float mx = sT[q2][0];
#pragma unroll
                    for (int i = 1; i < 16; ++i) mx = fmaxf(mx, sT[q2][i]);
                    mx = fmaxf(mx, __shfl_xor(mx, 32));
                    float mref = mrun[q2];
                    if (__any(mx > mref + 6.f)) { const float mn = fmaxf(mref, mx), corr = __builtin_amdgcn_exp2f(mref - mn); mrun[q2] = mn; mref = mn; lrun[q2] *= corr;
#pragma unroll
                        for (int db = 0; db < 2; ++db)
#pragma unroll
                            for (int i = 0; i < 16; ++i) oT[db][q2][i] *= corr; }
                    float ps = 0.f;
#pragma unroll
                    for (int i = 0; i < 16; ++i) { const float p = __builtin_amdgcn_exp2f(sT[q2][i] - mref); sT[q2][i] = p; ps += p; }
                    lrun[q2] += ps;
                }
#pragma unroll
                for (int s = 0; s < 2; ++s) {
                    bf16x8 pf2[2]; pf2[0] = pack_step(sT[0], s); pf2[1] = pack_step(sT[1], s);
#pragma unroll
                    for (int db = 0; db < 2; ++db) {
                        const LAS unsigned char* vp = lds + ATT_V_OFF + (kr0 + 16 * s + 4 * h + (i16 >> 2)) * ATT_VP + (32 * db + 16 * blk16 + 4 * (i16 & 3)) * 2;
                        const s16x4 lo = tr_read(vp), hi = tr_read(vp + 8 * ATT_VP);
                        const bf16x8 vf = __builtin_shufflevector(lo, hi, 0, 1, 2, 3, 4, 5, 6, 7);
                        oT[db][0] = MFMA32(vf, pf2[0], oT[db][0]); oT[db][1] = MFMA32(vf, pf2[1], oT[db][1]);
                    }
                }
            }
#pragma unroll
            for (int q2 = 0; q2 < 2; ++q2) { const float lt = lrun[q2] + __shfl_xor(lrun[q2], 32), rl = 1.f / lt;
                bf16* op = O + (qrow0 + 32 * q2 + r32) * 1024 + head * 64 + 4 * h;
#pragma unroll
                for (int db = 0; db < 2; ++db)
#pragma unroll
                    for (int g4 = 0; g4 < 4; ++g4) *(v2u*)(op + 32 * db + 8 * g4) = (v2u){cvtpk(oT[db][q2][4 * g4] * rl, oT[db][q2][4 * g4 + 1] * rl), cvtpk(oT[db][q2][4 * g4 + 2] * rl, oT[db][q2][4 * g4 + 3] * rl)}; }
            if (j < 7) {
#pragma unroll
                for (int i = 0; i < 2; ++i) { const int c = tid + 512 * i, r = c >> 3, ch = c & 7; const int lr = (nk0 + r) & 511;
                    *(LAS v4u*)(lds + lr * ATT_KP + ch * 16) = pf ? pk[i] : (v4u){0u, 0u, 0u, 0u}; *(LAS v4u*)(lds + ATT_V_OFF + lr * ATT_VP + ch * 16) = pf ? pv[i] : (v4u){0u, 0u, 0u, 0u}; }
#pragma unroll
                for (int q2 = 0; q2 < 2; ++q2)
#pragma unroll
                    for (int ks = 0; ks < 4; ++ks) qf[q2][ks] = qn[q2][ks];
            }
            __syncthreads();
        }
    }
}
constexpr int GP = 272;
constexpr int ZP = 132;
constexpr int PREP_QE = 0, PREP_KE = 64 * GP, PREP_KD = 2 * 64 * GP, PREP_Q = 3 * 64 * GP, PREP_K = 4 * 64 * GP, PREP_LR = 5 * 64 * GP, PREP_BS = PREP_LR + 64 * 80, PREP_Z = PREP_BS + 4 * 128 * 4, PREP_END = PREP_Z + 64 * ZP * 4;
static_assert(PREP_END <= 147456, "prep LDS");
DI float logsig2(float z) { return fminf(z, 0.f) * LOG2E - __builtin_amdgcn_logf(1.f + __builtin_amdgcn_exp2f(-fabsf(z) * LOG2E)); }
DI unsigned short cvt1(float x) { return (unsigned short)cvtpk(x, 0.f); }
DI void gla_prep(bf16* Gq, bf16* Gk, bf16* QEB, bf16* KDB, const float* LR, const float* w2f, const float* gbf, const float* w2b, const float* gbb, float* DL, bf16* ATT,
                 LAS unsigned char* lds, int blk, int G, int tid) {
    const int lane = tid & 63, wave = __builtin_amdgcn_readfirstlane(tid >> 6), d = tid & 127, tq = tid >> 7, fr = lane & 15, quad = lane >> 4;
    LAS float* bs = (LAS float*)(lds + PREP_BS); LAS float* zb = (LAS float*)(lds + PREP_Z);
    int hcur = -1; bf16x8 w2frag[2];
    for (int it = blk; it < NB * GH * 128; it += G) {
        const int h = it & 3, c = (it >> 2) & 127, b = it >> 9; const size_t row0 = (size_t)b * SEQ + 64 * c;
        const int unit = (b * GH + h) * 128 + c;
        if (h != hcur) {
#pragma unroll
            for (int dir = 0; dir < 2; ++dir) { const float* w2 = dir ? w2b : w2f; v4u p = {0u, 0u, 0u, 0u};
                if ((quad >> 1) == dir) { const int r0 = (quad & 1) * 8; const int col = h * 128 + 16 * wave + fr; float w[8];
#pragma unroll
                    for (int j = 0; j < 8; ++j) w[j] = w2[(r0 + j) * GQK + col];
                    p = (v4u){cvtpk(w[0], w[1]), cvtpk(w[2], w[3]), cvtpk(w[4], w[5]), cvtpk(w[6], w[7])}; }
                w2frag[dir] = __builtin_bit_cast(bf16x8, p); }
            hcur = h;
        }
        __syncthreads();
        { const f32x4 l = ((const f32x4*)(LR + row0 * 32))[tid]; const int r = tid >> 3, cq = tid & 7;
          *(LAS v2u*)(lds + PREP_LR + r * 80 + cq * 8) = (v2u){cvtpk(l.x, l.y), cvtpk(l.z, l.w)}; }
#pragma unroll
        for (int i = 0; i < 2; ++i) { const int p = tid + 512 * i, r = p >> 4, ch = p & 15; const size_t o = (row0 + r) * GQK + h * 128 + ch * 8;
            *(LAS v4u*)(lds + PREP_Q + r * GP + ch * 16) = *(const v4u*)(Gq + o); *(LAS v4u*)(lds + PREP_K + r * GP + ch * 16) = *(const v4u*)(Gk + o); }
        __syncthreads();
#pragma unroll 1
        for (int dir = 0; dir < 2; ++dir) {
            const float bias = (dir ? gbb : gbf)[h * 128 + d];
#pragma unroll
            for (int T = 0; T < 4; ++T) { const bf16x8 lf = *(const LAS bf16x8*)(lds + PREP_LR + (16 * T + fr) * 80 + quad * 16); f32x4 acc = {0.f, 0.f, 0.f, 0.f};
                acc = MFMA16(lf, dir ? w2frag[1] : w2frag[0], acc);
#pragma unroll
                for (int jj = 0; jj < 4; ++jj) zb[(16 * T + 4 * quad + jj) * ZP + 16 * wave + fr] = acc[jj]; }
            __syncthreads();
            float bl[16];
#pragma unroll
            for (int i = 0; i < 16; ++i) bl[i] = logsig2(zb[(16 * tq + i) * ZP + d] + bias) * (1.f / 16.f);
            if (dir == 0) {
#pragma unroll
                for (int i = 1; i < 16; ++i) bl[i] += bl[i - 1];
                bs[tq * 128 + d] = bl[15];
            } else {
#pragma unroll
                for (int i = 14; i >= 0; --i) bl[i] += bl[i + 1];
                bs[tq * 128 + d] = bl[0];
            }
            __syncthreads();
            const float s0 = bs[d], s1 = bs[128 + d], s2 = bs[256 + d], s3 = bs[384 + d]; const float blast = (s0 + s1) + (s2 + s3);
            float pre;
            if (dir == 0) pre = (tq > 0 ? s0 : 0.f) + (tq > 1 ? s1 : 0.f) + (tq > 2 ? s2 : 0.f);
            else pre = (tq < 3 ? s3 : 0.f) + (tq < 2 ? s2 : 0.f) + (tq < 1 ? s1 : 0.f);
            const float elast = __builtin_amdgcn_exp2f(blast);
#pragma unroll
            for (int i = 0; i < 16; ++i) { const int t = 16 * tq + i; const float eb = __builtin_amdgcn_exp2f(pre + bl[i]);
                const float qv = bf2f(*(const LAS unsigned short*)(lds + PREP_Q + t * GP + d * 2)), kv = bf2f(*(const LAS unsigned short*)(lds + PREP_K + t * GP + d * 2));
                const float ke = kv * __builtin_amdgcn_rcpf(eb);
                *(LAS unsigned short*)(lds + PREP_QE + t * GP + d * 2) = cvt1(qv * eb); *(LAS unsigned short*)(lds + PREP_KE + t * GP + d * 2) = cvt1(ke); *(LAS unsigned short*)(lds + PREP_KD + t * GP + d * 2) = cvt1(ke * elast); }
            if (tq == 0) DL[((size_t)dir * (NB * GH * 128) + unit) * 128 + d] = elast;
            __syncthreads();
            { bf16* QEo = dir ? QEB : Gq; bf16* KDo = dir ? KDB : Gk;
#pragma unroll
              for (int i = 0; i < 2; ++i) { const int p = tid + 512 * i, r = p >> 4, ch = p & 15; const size_t o = (row0 + r) * GQK + h * 128 + ch * 8;
                  *(v4u*)(QEo + o) = *(const LAS v4u*)(lds + PREP_QE + r * GP + ch * 16); *(v4u*)(KDo + o) = *(const LAS v4u*)(lds + PREP_KD + r * GP + ch * 16); } }
            const int tt = wave & 3;
            bf16x8 qf[4];
#pragma unroll
            for (int ks = 0; ks < 4; ++ks) qf[ks] = *(const LAS bf16x8*)(lds + PREP_QE + (16 * tt + fr) * GP + (32 * ks + 8 * quad) * 2);
            bf16* attp = ATT + ((size_t)dir * (NB * GH * 128) + unit) * 4096;
#pragma unroll
            for (int j = 0; j < 2; ++j) { const int st = 2 * (wave >> 2) + j; f32x4 acc = {0.f, 0.f, 0.f, 0.f};
#pragma unroll
                for (int ks = 0; ks < 4; ++ks) { const bf16x8 kf = *(const LAS bf16x8*)(lds + PREP_KE + (16 * st + fr) * GP + (32 * ks + 8 * quad) * 2); acc = MFMA16(kf, qf[ks], acc); }
                const int t = 16 * tt + fr, sb = 16 * st + 4 * quad;
#pragma unroll
                for (int jj = 0; jj < 4; ++jj) { const int s = sb + jj; const bool keep = dir ? (s >= t) : (s <= t); if (!keep) acc[jj] = 0.f; }
                *(v2u*)(attp + t * 64 + sb) = (v2u){cvtpk(acc[0], acc[1]), cvtpk(acc[2], acc[3])}; }
            __syncthreads();
        }
    }
}

constexpr int SC_AP = 144, SC_VP = 144;
constexpr int SC_ATT = 0, SC_QE = 64 * SC_AP, SC_KD = SC_QE + 64 * GP, SC_V = SC_KD + 64 * GP, SC_DL = SC_V + 64 * SC_VP, SC_BUF = SC_DL + 512, SC_ST = 2 * SC_BUF, SC_END = SC_ST + 64 * GP;
static_assert(SC_END <= 131072, "scan LDS");
DI void gla_scan(const bf16* QEF, const bf16* QEB, const bf16* KDF, const bf16* KDB, const bf16* Gv, const float* DL, const bf16* ATT, bf16* OF, bf16* OB, LAS unsigned char* lds, int blk, int G, int tid) {
    const int lane = tid & 63, wave = __builtin_amdgcn_readfirstlane(tid >> 6), fr = lane & 15, quad = lane >> 4;
    const int vblk = (G % 8 == 0) ? (blk % 8) * (G / 8) + blk / 8 : blk;
    for (int u = vblk; u < NB * GH * 2 * 4; u += G) {
        const int dvs = u & 3, dir = (u >> 2) & 1, h = (u >> 3) & 3, b = u >> 5;
        const bf16* QE = dir ? QEB : QEF; const bf16* KD = dir ? KDB : KDF; bf16* OUT = dir ? OB : OF;
        const float* DLu = DL + ((size_t)dir * (NB * GH * 128) + (b * GH + h) * 128) * 128; const bf16* ATTu = ATT + ((size_t)dir * (NB * GH * 128) + (b * GH + h) * 128) * 4096;
        f32x4 S[4];
#pragma unroll
        for (int n = 0; n < 4; ++n) S[n] = (f32x4){0.f, 0.f, 0.f, 0.f};
        v4u raA, rqA[2], rkA[2], rvA, rdA, raB, rqB[2], rkB[2], rvB, rdB;
        const int a_r = tid >> 3, a_c = tid & 7;
#define SC_LOAD(X, c_) do { const int cl_ = (c_) < 127 ? (c_) : 127; const int cc_ = dir ? 127 - cl_ : cl_; const size_t row0_ = (size_t)b * SEQ + 64 * cc_; \
            ra##X = *(const v4u*)(ATTu + (size_t)cc_ * 4096 + tid * 8); \
            rv##X = *(const v4u*)(Gv + (row0_ + a_r) * GVC + h * 256 + dvs * 64 + a_c * 8); \
            _Pragma("unroll") for (int i_ = 0; i_ < 2; ++i_) { const int p_ = tid + 512 * i_, r_ = p_ >> 4, c2_ = p_ & 15; \
                rq##X[i_] = *(const v4u*)(QE + (row0_ + r_) * GQK + h * 128 + c2_ * 8); rk##X[i_] = *(const v4u*)(KD + (row0_ + r_) * GQK + h * 128 + c2_ * 8); } \
            rd##X = *(const v4u*)(DLu + (size_t)cc_ * 128 + (tid & 31) * 4); } while (0)
#define SC_STORE(X, bufo) do { *(LAS v4u*)(lds + (bufo) + SC_ATT + a_r * SC_AP + a_c * 16) = ra##X; *(LAS v4u*)(lds + (bufo) + SC_V + a_r * SC_VP + a_c * 16) = rv##X; \
            _Pragma("unroll") for (int i_ = 0; i_ < 2; ++i_) { const int p_ = tid + 512 * i_, r_ = p_ >> 4, c2_ = p_ & 15; \
                *(LAS v4u*)(lds + (bufo) + SC_QE + r_ * GP + c2_ * 16) = rq##X[i_]; *(LAS v4u*)(lds + (bufo) + SC_KD + r_ * GP + c2_ * 16) = rk##X[i_]; } \
            if (tid < 32) *(LAS v4u*)(lds + (bufo) + SC_DL + tid * 16) = rd##X; } while (0)
#define SC_STEP(c_, bo) do { const int cc = dir ? 127 - (c_) : (c_); \
            _Pragma("unroll") for (int n = 0; n < 4; ++n) *(LAS v2u*)(lds + SC_ST + (16 * n + fr) * GP + (16 * wave + 4 * quad) * 2) = (v2u){cvtpk(S[n][0], S[n][1]), cvtpk(S[n][2], S[n][3])}; \
              \
            const int tt = wave & 3, nb = 2 * (wave >> 2); bf16x8 af[2], qf[4], vf[2][4], kf[2], sf[2][4]; \
            _Pragma("unroll") for (int ks = 0; ks < 2; ++ks) af[ks] = *(const LAS bf16x8*)(lds + (bo) + SC_ATT + (16 * tt + fr) * SC_AP + (32 * ks + 8 * quad) * 2); \
            _Pragma("unroll") for (int ks = 0; ks < 4; ++ks) qf[ks] = *(const LAS bf16x8*)(lds + (bo) + SC_QE + (16 * tt + fr) * GP + (32 * ks + 8 * quad) * 2); \
            _Pragma("unroll") for (int ks = 0; ks < 2; ++ks) { \
                _Pragma("unroll") for (int n = 0; n < 4; ++n) { const LAS unsigned char* vp = lds + (bo) + SC_V + (32 * ks + 8 * quad + (fr >> 2)) * SC_VP + (16 * n + 4 * (fr & 3)) * 2; \
                    const s16x4 lo = tr_read(vp), hi = tr_read(vp + 4 * SC_VP); vf[ks][n] = __builtin_shufflevector(lo, hi, 0, 1, 2, 3, 4, 5, 6, 7); } \
                const LAS unsigned char* kp = lds + (bo) + SC_KD + (32 * ks + 8 * quad + (fr >> 2)) * GP + (16 * wave + 4 * (fr & 3)) * 2; \
                const s16x4 klo = tr_read(kp), khi = tr_read(kp + 4 * GP); kf[ks] = __builtin_shufflevector(klo, khi, 0, 1, 2, 3, 4, 5, 6, 7); } \
            const f32x4 dl = *(const LAS f32x4*)(lds + (bo) + SC_DL + (16 * wave + 4 * quad) * 4); \
            __syncthreads(); \
            _Pragma("unroll") for (int j = 0; j < 2; ++j) _Pragma("unroll") for (int ks = 0; ks < 4; ++ks) sf[j][ks] = *(const LAS bf16x8*)(lds + SC_ST + (16 * (nb + j) + fr) * GP + (32 * ks + 8 * quad) * 2); \
            f32x4 acc0 = {0.f, 0.f, 0.f, 0.f}, acc1 = {0.f, 0.f, 0.f, 0.f}; \
            _Pragma("unroll") for (int ks = 0; ks < 2; ++ks) { acc0 = MFMA16((nb ? vf[ks][2] : vf[ks][0]), af[ks], acc0); acc1 = MFMA16((nb ? vf[ks][3] : vf[ks][1]), af[ks], acc1); } \
            _Pragma("unroll") for (int n = 0; n < 4; ++n) S[n] = S[n] * dl; \
            _Pragma("unroll") for (int ks = 0; ks < 2; ++ks) _Pragma("unroll") for (int n = 0; n < 4; ++n) S[n] = MFMA16(kf[ks], vf[ks][n], S[n]); \
            _Pragma("unroll") for (int ks = 0; ks < 4; ++ks) { acc0 = MFMA16(sf[0][ks], qf[ks], acc0); acc1 = MFMA16(sf[1][ks], qf[ks], acc1); } \
            { const size_t orow = (size_t)b * SEQ + 64 * cc + 16 * tt + fr; bf16* op = OUT + orow * GVC + h * 256 + dvs * 64 + 16 * nb + 4 * quad; \
              *(v2u*)op = (v2u){cvtpk(acc0[0], acc0[1]), cvtpk(acc0[2], acc0[3])}; *(v2u*)(op + 16) = (v2u){cvtpk(acc1[0], acc1[1]), cvtpk(acc1[2], acc1[3])}; } } while (0)
        __syncthreads();
        SC_LOAD(A, 0); SC_STORE(A, 0); SC_LOAD(A, 1);
        __syncthreads();
        for (int c = 0; c < 128; c += 2) {
            SC_LOAD(B, c + 2);
            SC_STEP(c, 0);
            SC_STORE(A, SC_BUF);
            __syncthreads();
            SC_LOAD(A, c + 3);
            SC_STEP(c + 1, SC_BUF);
            SC_STORE(B, 0);
            __syncthreads();
        }
#undef SC_STEP
#undef SC_LOAD
#undef SC_STORE
    }
}
enum Phase { PH_PRO = 0, PH_QKV, PH_ATT, PH_AOUT, PH_UP0, PH_DN0, PH_GIN, PH_GPREP, PH_GSCAN, PH_GNORM, PH_GOUT, PH_UP1, PH_DN1, PH_LN4, PH_COUNT };

__global__ void __launch_bounds__(NTHREADS, 2) fwd_kernel(Args a) {
    extern __shared__ __attribute__((aligned(16))) unsigned char lds_raw[];
    LAS unsigned char* lds = (LAS unsigned char*)lds_raw;
    cg::grid_group grid = cg::this_grid();
    const int tid = threadIdx.x, lane = tid & 63, wave = __builtin_amdgcn_readfirstlane(tid >> 6);
    const int G = gridDim.x, blk = blockIdx.x;
    const int gw = blk * NWAVES + wave, NGW = G * NWAVES;
    unsigned char* ws = a.ws;
    bf16* XB = (bf16*)(ws + WS_XB); float* ST1 = (float*)(ws + WS_ST1); float* ST2 = (float*)(ws + WS_ST2); float* ST3 = (float*)(ws + WS_ST3); float* FOLD = (float*)(ws + WS_FOLD);
    bf16* HB = (bf16*)(ws + WS_R);
    const int lo = a.ph_lo, hi = a.ph_hi;
    if (a.ph_lo < 0) grid.sync();
    if (tid < 32) ((LAS unsigned*)(lds + MISC_OFF))[tid] = 0u;
    __syncthreads();
    XcdBarrier bar = xcd_barrier_post((unsigned*)(ws + WS_CTL) + 1024, (volatile LAS unsigned*)(lds + MISC_OFF) + 8);
#define IN(k) (lo <= (k) && (k) < hi)
#define SEAM(k) do { if (IN(k) && IN((k) + 1)) xcd_barrier(bar); } while (0)
#define GEMM_RUN(EPI, g, S, E) pg8::gemm_phase<EPI, pg8::StaticOrder, PG8_ALIGN, PG8_SP2>(lds, g, S, E)
    if (IN(PH_PRO)) { p0_prologue(a, lds, gw, NGW, wave, lane); } SEAM(PH_PRO);
    if (IN(PH_QKV)) {
        pg8::Gemm g{XB, (const bf16*)(ws + WS_WAIN), M, A_IN, DM}; pg8::StaticOrder S; S.init(M, A_IN, G, blk);
        pg8::EpiQKV E{(bf16*)(ws + WS_Q), (bf16*)(ws + WS_K), (bf16*)(ws + WS_V), (const float*)(ws + WS_COS), (const float*)(ws + WS_SIN), 0.125f * LOG2E};
        GEMM_RUN(pg8::EpiQKV, g, S, E);
    } SEAM(PH_QKV);
    if (IN(PH_ATT)) { attn_mfma((const bf16*)(ws + WS_Q), (const bf16*)(ws + WS_K), (const bf16*)(ws + WS_V), (bf16*)(ws + WS_O), a.in[3], lds, blk, G, tid); } SEAM(PH_ATT);
    if (IN(PH_AOUT)) {
        pg8::Gemm g{(const bf16*)(ws + WS_O), (const bf16*)(ws + WS_WAOUT), M, DM, DM}; pg8::StaticOrder S; S.init(M, DM, G, blk);
        pg8::EpiRes<2> E{nullptr, XB, nullptr, nullptr, nullptr, XB, ST1};
        GEMM_RUN(pg8::EpiRes<2>, g, S, E);
    } SEAM(PH_AOUT);
    if (IN(PH_UP0)) {
        pg8::Gemm g{XB, (const bf16*)(ws + WS_W1), M, FF, DM}; pg8::StaticOrder S; S.init(M, FF, G, blk);
        pg8::EpiSqRelu E{HB, FF, pg8::LnFold{ST1, FOLD, FOLD + 4096}};
        GEMM_RUN(pg8::EpiSqRelu, g, S, E);
    } SEAM(PH_UP0);
    if (IN(PH_DN0)) {
        pg8::Gemm g{HB, (const bf16*)(ws + WS_W2), M, DM, FF}; pg8::StaticOrder S; S.init(M, DM, G, blk);
        pg8::EpiRes<1> E{nullptr, XB, ST1, a.in[12], a.in[13], XB, ST2};
        GEMM_RUN(pg8::EpiRes<1>, g, S, E);
    } SEAM(PH_DN0);
    if (IN(PH_GIN)) {
        pg8::Gemm g{XB, (const bf16*)(ws + WS_WGIN), M, G_INP, DM}; pg8::StaticOrder S; S.init(M, G_INP, G, blk);
        pg8::EpiGin E{(bf16*)(ws + WS_GQ), (bf16*)(ws + WS_GK), (bf16*)(ws + WS_GV), (bf16*)(ws + WS_GR), (float*)(ws + WS_LR), 0.08838834764831845f, pg8::LnFold{ST2, FOLD + 8192, FOLD + 12288}};
        GEMM_RUN(pg8::EpiGin, g, S, E);
    } SEAM(PH_GIN);
    if (IN(PH_GPREP)) {
        gla_prep((bf16*)(ws + WS_GQ), (bf16*)(ws + WS_GK), (bf16*)(ws + WS_QEB), (bf16*)(ws + WS_KDB), (const float*)(ws + WS_LR), a.in[6], a.in[7], a.in[8], a.in[9],
                 (float*)(ws + WS_DL), (bf16*)(ws + WS_ATT), lds, blk, G, tid);
    } SEAM(PH_GPREP);
    if (IN(PH_GSCAN)) {
        gla_scan((const bf16*)(ws + WS_GQ), (const bf16*)(ws + WS_QEB), (const bf16*)(ws + WS_GK), (const bf16*)(ws + WS_KDB), (const bf16*)(ws + WS_GV), (const float*)(ws + WS_DL), (const bf16*)(ws + WS_ATT),
                 (bf16*)a.out, (bf16*)a.out + (size_t)M * GVC, lds, blk, G, tid);
    } SEAM(PH_GSCAN);
    if (IN(PH_GNORM)) { gla_norm_pass((const bf16*)a.out, (const bf16*)a.out + (size_t)M * GVC, (const bf16*)(ws + WS_GR), a.in[10], (bf16*)a.out, gw, NGW, lane); } SEAM(PH_GNORM);
    if (IN(PH_GOUT)) {
        pg8::Gemm g{(const bf16*)a.out, (const bf16*)(ws + WS_WGOUT), M, DM, DM}; pg8::StaticOrder S; S.init(M, DM, G, blk);
        pg8::EpiRes<1> E{nullptr, XB, ST2, a.in[16], a.in[17], XB, ST3};
        GEMM_RUN(pg8::EpiRes<1>, g, S, E);
    } SEAM(PH_GOUT);
    if (IN(PH_UP1)) {
        pg8::Gemm g{XB, (const bf16*)(ws + WS_W1 + 8 * MiB), M, FF, DM}; pg8::StaticOrder S; S.init(M, FF, G, blk);
        pg8::EpiSqRelu E{HB, FF, pg8::LnFold{ST3, FOLD + 16384, FOLD + 20480}};
        GEMM_RUN(pg8::EpiSqRelu, g, S, E);
    } SEAM(PH_UP1);
    if (IN(PH_DN1)) {
        pg8::Gemm g{HB, (const bf16*)(ws + WS_W2 + 8 * MiB), M, DM, FF}; pg8::StaticOrder S; S.init(M, DM, G, blk);
        pg8::EpiRes<1> E{nullptr, XB, ST3, a.in[12] + DM, a.in[13] + DM, XB, (float*)(ws + WS_ST4)};
        GEMM_RUN(pg8::EpiRes<1>, g, S, E);
    } SEAM(PH_DN1);
    if (IN(PH_LN4)) { ln_final_pass(XB, (const float*)(ws + WS_ST4), a.in[16] + DM, a.in[17] + DM, a.out, gw, NGW, lane); }
#undef IN
#undef SEAM
#undef GEMM_RUN
}

#ifndef MK_MULTI
#define MK_MULTI 0
#endif
extern "C" void kernel_launch(void* const* d_in, const int* in_sizes, int n_in, void* d_out, int out_size, void* d_ws, size_t ws_size, hipStream_t stream) {
    static int grid = 0;
    if (grid == 0) {
        if (n_in != 18 || in_sizes[0] != M * DM || out_size != M * DM || ws_size < WS_END) { fprintf(stderr, "kernel_launch: unexpected shapes (n_in %d, in0 %d, out %d, ws %zu); nothing launched\n", n_in, n_in > 0 ? in_sizes[0] : -1, out_size, ws_size); grid = -1; return; }
        int dev = 0, cus = 0, per_cu = 0;
        hipGetDevice(&dev); hipDeviceGetAttribute(&cus, hipDeviceAttributeMultiprocessorCount, dev);
        if (hipFuncSetAttribute((const void*)fwd_kernel, hipFuncAttributeMaxDynamicSharedMemorySize, LDS_BYTES) != hipSuccess) { fprintf(stderr, "kernel_launch: hipFuncSetAttribute failed\n"); grid = -1; return; }
        hipOccupancyMaxActiveBlocksPerMultiprocessor(&per_cu, (const void*)fwd_kernel, NTHREADS, LDS_BYTES);
        if (per_cu < 1) { fprintf(stderr, "kernel_launch: occupancy query says %d blocks per CU\n", per_cu); per_cu = 1; }
        (void)hipGetLastError();
        grid = cus * 1;
        fprintf(stderr, "kernel_launch: cus %d per_cu %d grid %d\n", cus, per_cu, grid);
    }
    if (grid < 0) return;
    if (hipMemsetAsync((char*)d_ws + WS_CTL, 0, CTL_ZERO_BYTES, stream) != hipSuccess) { fprintf(stderr, "kernel_launch: memset failed\n"); return; }
    Args a{};
    for (int i = 0; i < 18; ++i) a.in[i] = (const float*)d_in[i];
    a.out = (float*)d_out; a.ws = (unsigned char*)d_ws;
#if MK_MULTI
    for (int ph = 0; ph < PH_COUNT; ++ph) { a.ph_lo = ph; a.ph_hi = ph + 1; hipLaunchKernelGGL(fwd_kernel, dim3(grid), dim3(NTHREADS), LDS_BYTES, stream, a); }
#else
    a.ph_lo = 0; a.ph_hi = PH_COUNT;
    void* args[] = {&a};
    hipError_t e = hipLaunchCooperativeKernel((const void*)fwd_kernel, dim3(grid), dim3(NTHREADS), args, LDS_BYTES, stream);
    if (e != hipSuccess) fprintf(stderr, "cooperative launch failed: %s (grid %d)\n", hipGetErrorString(e), grid);
#endif
}
```

```cpp
#include <hip/hip_runtime.h>
#include <hip/hip_cooperative_groups.h>
#include <cstdio>
#include <cstdint>
#include <cmath>
namespace cg = cooperative_groups;
namespace pg8 {
#define PG8_LAS __attribute__((address_space(3)))
typedef unsigned short bf16_t;
typedef short bf16x8 __attribute__((ext_vector_type(8)));
typedef float f32x4 __attribute__((ext_vector_type(4)));
typedef unsigned u32x4 __attribute__((ext_vector_type(4)));
constexpr int BM = 256, BK = 64, HALF = 128, HTB = HALF * BK * 2  , STAGE_BYTES = 8 * HTB, NXCD = 8, WGM = 8;

__host__ __device__ __forceinline__ int lds_byte(int r, int c) { const int st = (r >> 4) * 2 + (c >> 5), rr = r & 15, cc = c & 31, ob = rr * 64 + cc * 2; return st * 1024 + (ob ^ (((ob >> 9) & 1) << 5)); }
__host__ __device__ __forceinline__ void stage_rc(int b, int& R, int& C) { const int st = b / 1024, sb = b % 1024, swz = sb ^ (((sb >> 9) & 1) << 5); R = (st >> 1) * 16 + swz / 64; C = (st & 1) * 32 + (swz % 64) / 2; }
__host__ __device__ __forceinline__ int perm32(int rho) { const int n = rho >> 4, i = rho & 15; return 8 * (i >> 2) + 4 * n + (i & 3); }

struct Unit { int pm, pn; };
struct Gemm { const bf16_t* A; const bf16_t* Bt; int M, N, K; };

struct StaticOrder {
    int nM, nN, nwg, G, c;
    __host__ __device__ void init(int M, int N, int G_, int c_) { nM = M / BM; nN = N / BM; nwg = nM * nN; G = G_; c = c_; }
    __host__ __device__ bool next(int i, Unit& u) const {
        const long L = (long)i * G + c; if (L >= nwg) return false;
        int wgid = (int)L; { const int q = nwg / NXCD, r = nwg % NXCD, xcd = wgid % NXCD, off = wgid / NXCD; wgid = (xcd < r ? xcd * (q + 1) : r * (q + 1) + (xcd - r) * q) + off; }
        const int nig = WGM * nN, gid = wgid / nig, fm = gid * WGM, gsz = (nM - fm) < WGM ? (nM - fm) : WGM;
        u.pm = fm + ((wgid % nig) % gsz); u.pn = (wgid % nig) / gsz; return true;
    }
    __device__ __forceinline__ void a_ready(const Unit&) const {}
    __device__ __forceinline__ void done(const Unit&) const {}
};

__device__ __forceinline__ unsigned cvt_pk_bf16(float lo, float hi) { unsigned r; asm volatile("v_cvt_pk_bf16_f32 %0, %1, %2" : "=v"(r) : "v"(lo), "v"(hi)); return r; }
typedef float f32x2 __attribute__((ext_vector_type(2)));
typedef unsigned u32x2 __attribute__((ext_vector_type(2)));
__device__ __forceinline__ u32x4 pack8(f32x4 a, f32x4 b) { u32x4 w; w.x = cvt_pk_bf16(a[0], a[1]); w.y = cvt_pk_bf16(a[2], a[3]); w.z = cvt_pk_bf16(b[0], b[1]); w.w = cvt_pk_bf16(b[2], b[3]); return w; }

struct EpiQKV {
    static constexpr bool PERM = true, AFTER_DRAIN = false;
    bf16_t* Q; bf16_t* Kb; bf16_t* Vb; const float* cosT; const float* sinT; float qscale;
    __device__ __forceinline__ void operator()(const f32x4 (&acc)[2][2][4][2], const Unit& u, int wr, int wc, int fr, int fq) const {
        const int row0 = u.pm * BM + wr * 64 + fr; const int pn = u.pn;
        if (pn == 5) {
            const int col0 = wc * 32 + 8 * fq;
#pragma unroll
            for (int ai = 0; ai < 2; ++ai)
#pragma unroll
                for (int m = 0; m < 4; ++m) { bf16_t* rowp = Vb + (size_t)(row0 + ai * HALF + m * 16) * 256 + col0;
#pragma unroll
                    for (int bj = 0; bj < 2; ++bj) *(u32x4*)(rowp + bj * HALF) = pack8(acc[ai][bj][m][0], acc[ai][bj][m][1]); }
        } else {
            bf16_t* base; int ld, colt; float sc;
            if (pn < 4) { base = Q; ld = 1024; colt = pn * 256; sc = qscale; } else { base = Kb; ld = 256; colt = 0; sc = 1.f; }
            const int col0 = colt + wc * 32 + 8 * fq; const int d1 = 16 * (wc & 1) + 4 * fq;
            f32x4 cs[2][2], sn[2][2];
#define QKV_LOAD(bt, bf) do { _Pragma("unroll") for (int i_ = 0; i_ < 2; ++i_) { const int r8_ = 2 * (bt) + i_; const int row_ = row0 + (r8_ >> 2) * HALF + (r8_ & 3) * 16; \
                cs[bf][i_] = *(const f32x4*)(cosT + (size_t)row_ * 32 + d1); sn[bf][i_] = *(const f32x4*)(sinT + (size_t)row_ * 32 + d1); } } while (0)
            QKV_LOAD(0, 0);
#pragma unroll
            for (int bt = 0; bt < 4; ++bt) {
                if (bt + 1 < 4) { if ((bt + 1) & 1) QKV_LOAD(bt + 1, 1); else QKV_LOAD(bt + 1, 0); }
#pragma unroll
                for (int i = 0; i < 2; ++i) { const int r8 = 2 * bt + i, ai = r8 >> 2, m = r8 & 3; const int row = row0 + ai * HALF + m * 16;
                    const f32x4 c4 = cs[bt & 1][i], s4 = sn[bt & 1][i];
#pragma unroll
                    for (int bj = 0; bj < 2; ++bj) { const f32x4 t1 = acc[ai][bj][m][0], t2 = acc[ai][bj][m][1];
                        const f32x4 o1 = (t1 * c4 - t2 * s4) * sc, o2 = (t2 * c4 + t1 * s4) * sc;
                        *(u32x4*)(base + (size_t)row * ld + col0 + bj * HALF) = pack8(o1, o2); } }
            }
#undef QKV_LOAD
        }
    }
};
template <int MODE> struct EpiRes {
    static constexpr bool PERM = true, AFTER_DRAIN = false;
    const float* Rf; const bf16_t* Rb; const float* stats; const float* g; const float* b; bf16_t* ZB; float* STout;
    static constexpr float alpha = 1.41421356237309515f;
    __device__ __forceinline__ void operator()(const f32x4 (&acc)[2][2][4][2], const Unit& u, int wr, int wc, int fr, int fq) const {
        const int row0 = u.pm * BM + wr * 64 + fr, col0 = u.pn * BM + wc * 32 + 8 * fq;
        f32x4 rf[2][2][2]; u32x4 rbb[2][2]; f32x2 sb[2];
#define RES_LOAD(r8_, bf) do { const int row_ = row0 + ((r8_) >> 2) * HALF + ((r8_) & 3) * 16; const size_t off_ = (size_t)row_ * 1024 + col0; \
            if constexpr (MODE >= 1) { if constexpr (MODE == 1) sb[bf] = *(const f32x2*)(stats + 2 * (size_t)row_); rbb[bf][0] = *(const u32x4*)(Rb + off_); rbb[bf][1] = *(const u32x4*)(Rb + off_ + HALF); } \
            else { rf[bf][0][0] = *(const f32x4*)(Rf + off_); rf[bf][0][1] = *(const f32x4*)(Rf + off_ + 4); rf[bf][1][0] = *(const f32x4*)(Rf + off_ + HALF); rf[bf][1][1] = *(const f32x4*)(Rf + off_ + HALF + 4); } } while (0)
        RES_LOAD(0, 0);
        f32x4 gg[2][2], bb[2][2];
        if constexpr (MODE == 1) {
#pragma unroll
            for (int bj = 0; bj < 2; ++bj)
#pragma unroll
                for (int n = 0; n < 2; ++n) { gg[bj][n] = *(const f32x4*)(g + col0 + bj * HALF + 4 * n); bb[bj][n] = *(const f32x4*)(b + col0 + bj * HALF + 4 * n); }
        }
#pragma unroll
        for (int r8 = 0; r8 < 8; ++r8) {
            if (r8 + 1 < 8) RES_LOAD(r8 + 1, (r8 + 1) & 1);
            const int ai = r8 >> 2, m = r8 & 3; const int row = row0 + ai * HALF + m * 16; const size_t off = (size_t)row * 1024 + col0;
            float mean = 0.f, rstd = 1.f; if constexpr (MODE == 1) { const f32x2 st = sb[r8 & 1]; mean = st.x * (1.f / 1024.f); rstd = __builtin_amdgcn_rsqf(st.y * (1.f / 1024.f) - mean * mean + 1e-5f); }
            float s = 0.f, ss = 0.f;
#pragma unroll
            for (int bj = 0; bj < 2; ++bj) { f32x4 r0, r1;
                if constexpr (MODE >= 1) { const u32x4 w = rbb[r8 & 1][bj];
                    r0 = (f32x4){__builtin_bit_cast(float, w.x << 16), __builtin_bit_cast(float, w.x & 0xffff0000u), __builtin_bit_cast(float, w.y << 16), __builtin_bit_cast(float, w.y & 0xffff0000u)};
                    r1 = (f32x4){__builtin_bit_cast(float, w.z << 16), __builtin_bit_cast(float, w.z & 0xffff0000u), __builtin_bit_cast(float, w.w << 16), __builtin_bit_cast(float, w.w & 0xffff0000u)};
                    if constexpr (MODE == 1) { r0 = (r0 - mean) * rstd * gg[bj][0] + bb[bj][0]; r1 = (r1 - mean) * rstd * gg[bj][1] + bb[bj][1]; } }
                else { r0 = rf[r8 & 1][bj][0]; r1 = rf[r8 & 1][bj][1]; }
                const f32x4 o0 = r0 * alpha + acc[ai][bj][m][0], o1 = r1 * alpha + acc[ai][bj][m][1];
                *(u32x4*)(ZB + off + bj * HALF) = pack8(o0, o1);
                s += ((o0[0] + o0[1]) + (o0[2] + o0[3])) + ((o1[0] + o1[1]) + (o1[2] + o1[3]));
                ss += ((o0[0] * o0[0] + o0[1] * o0[1]) + (o0[2] * o0[2] + o0[3] * o0[3])) + ((o1[0] * o1[0] + o1[1] * o1[1]) + (o1[2] * o1[2] + o1[3] * o1[3])); }
            if (STout) { s += __shfl_xor(s, 16); s += __shfl_xor(s, 32); ss += __shfl_xor(ss, 16); ss += __shfl_xor(ss, 32);
                if (fq == 0) { __hip_atomic_fetch_add(STout + 2 * (size_t)row, s, __ATOMIC_RELAXED, __HIP_MEMORY_SCOPE_AGENT); __hip_atomic_fetch_add(STout + 2 * (size_t)row + 1, ss, __ATOMIC_RELAXED, __HIP_MEMORY_SCOPE_AGENT); } }
        }
#undef RES_LOAD
    }
};
struct LnFold { const float* st; const float* cs; const float* cb; };
__device__ __forceinline__ void ln_rows8(const float* st, int row0, float (&mean)[8], float (&rstd)[8]) {
    f32x2 v[8];
#pragma unroll
    for (int r8 = 0; r8 < 8; ++r8) v[r8] = *(const f32x2*)(st + 2 * (size_t)(row0 + (r8 >> 2) * HALF + (r8 & 3) * 16));
#pragma unroll
    for (int r8 = 0; r8 < 8; ++r8) { mean[r8] = v[r8].x * (1.f / 1024.f); rstd[r8] = __builtin_amdgcn_rsqf(v[r8].y * (1.f / 1024.f) - mean[r8] * mean[r8] + 1e-5f); }
}
struct EpiSqRelu {
    static constexpr bool PERM = true, AFTER_DRAIN = false;
    bf16_t* O; int ldc; LnFold f;
    __device__ __forceinline__ void operator()(const f32x4 (&acc)[2][2][4][2], const Unit& u, int wr, int wc, int fr, int fq) const {
        const int row0 = u.pm * BM + wr * 64, col0 = u.pn * BM + wc * 32 + 8 * fq; const f32x4 zero = {0.f, 0.f, 0.f, 0.f};
        f32x4 cs[2][2], cb[2][2];
#pragma unroll
        for (int bj = 0; bj < 2; ++bj)
#pragma unroll
            for (int n = 0; n < 2; ++n) { cs[bj][n] = *(const f32x4*)(f.cs + col0 + bj * HALF + 4 * n); cb[bj][n] = *(const f32x4*)(f.cb + col0 + bj * HALF + 4 * n); }
        float mean8[8], rstd8[8]; ln_rows8(f.st, row0 + fr, mean8, rstd8);
        const int hb = fr >> 3, r7 = fr & 7; const int pcol = u.pn * BM + 64 * wc + 32 * hb + 8 * fq;
#pragma unroll
        for (int ai = 0; ai < 2; ++ai)
#pragma unroll
            for (int m = 0; m < 4; ++m) { const float mean = mean8[ai * 4 + m], rstd = rstd8[ai * 4 + m];
                u32x4 d[2];
#pragma unroll
                for (int bj = 0; bj < 2; ++bj) {
                    f32x4 v0 = (acc[ai][bj][m][0] - cs[bj][0] * mean) * rstd + cb[bj][0], v1 = (acc[ai][bj][m][1] - cs[bj][1] * mean) * rstd + cb[bj][1];
                    v0 = __builtin_elementwise_max(v0, zero); v1 = __builtin_elementwise_max(v1, zero); d[bj] = pack8(v0 * v0, v1 * v1); }
                const u32x4 snd = hb ? d[0] : d[1]; u32x4 rcv;
                rcv.x = __shfl_xor(snd.x, 8); rcv.y = __shfl_xor(snd.y, 8); rcv.z = __shfl_xor(snd.z, 8); rcv.w = __shfl_xor(snd.w, 8);
                const int rbase = row0 + ai * HALF + m * 16;
                __builtin_nontemporal_store(hb ? rcv : d[0], (u32x4*)(O + (size_t)(rbase + r7) * ldc + pcol));
                __builtin_nontemporal_store(hb ? d[1] : rcv, (u32x4*)(O + (size_t)(rbase + 8 + r7) * ldc + pcol)); }
    }
};
struct EpiGin {
    static constexpr bool PERM = true, AFTER_DRAIN = false;
    bf16_t* Gq; bf16_t* Gk; bf16_t* Gv; bf16_t* Gr; float* LR; float qscale; LnFold f;
    __device__ __forceinline__ void operator()(const f32x4 (&acc)[2][2][4][2], const Unit& u, int wr, int wc, int fr, int fq) const {
        const int row0 = u.pm * BM + wr * 64 + fr; const int pn = u.pn; const int ccol0 = pn * BM + wc * 32 + 8 * fq;
        f32x4 cs[2][2], cb[2][2];
#pragma unroll
        for (int bj = 0; bj < 2; ++bj)
#pragma unroll
            for (int n = 0; n < 2; ++n) { cs[bj][n] = *(const f32x4*)(f.cs + ccol0 + bj * HALF + 4 * n); cb[bj][n] = *(const f32x4*)(f.cb + ccol0 + bj * HALF + 4 * n); }
        float mean8[8], rstd8[8]; ln_rows8(f.st, row0, mean8, rstd8);
        bf16_t* base; int ld, colt; float sc = 1.f;
        if (pn < 2) { base = Gq; ld = 512; colt = pn * 256; sc = qscale; } else if (pn < 4) { base = Gk; ld = 512; colt = (pn - 2) * 256; }
        else if (pn < 8) { base = Gv; ld = 1024; colt = (pn - 4) * 256; } else { base = Gr; ld = 1024; colt = (pn - 8) * 256; }
        const int col0 = colt + wc * 32 + 8 * fq;
#pragma unroll
        for (int ai = 0; ai < 2; ++ai)
#pragma unroll
            for (int m = 0; m < 4; ++m) { const int row = row0 + ai * HALF + m * 16; const float mean = mean8[ai * 4 + m], rstd = rstd8[ai * 4 + m];
#pragma unroll
                for (int bj = 0; bj < 2; ++bj) {
                    const f32x4 v0 = ((acc[ai][bj][m][0] - cs[bj][0] * mean) * rstd + cb[bj][0]) * sc, v1 = ((acc[ai][bj][m][1] - cs[bj][1] * mean) * rstd + cb[bj][1]) * sc;
                    if (pn == 12) { if (bj == 0 && wc == 0) { float* p = LR + (size_t)row * 32 + 8 * fq; *(f32x4*)p = v0; *(f32x4*)(p + 4) = v1; } }
                    else *(u32x4*)(base + (size_t)row * ld + col0 + bj * HALF) = pack8(v0, v1); } }
    }
};

template <class Epi, class Sched, bool ALIGN_EPI = false, bool SP2 = false>
__device__ __forceinline__ void gemm_phase(PG8_LAS unsigned char* lds, const Gemm g, const Sched& S, const Epi& E) {
    const int tid = threadIdx.x, wid = __builtin_amdgcn_readfirstlane(tid >> 6), lane = tid & 63, wr = wid >> 2, wc = wid & 3, fr = lane & 15, fq = lane >> 4;
    const int K = g.K, nt = K / BK;
    unsigned voffA[2], voffB[2];
#pragma unroll
    for (int i = 0; i < 2; ++i) { int R, C; stage_rc(tid * 16 + i * 8192, R, C); const int Rb = Epi::PERM ? ((R & ~31) + perm32(R & 31)) : R;
        voffA[i] = (unsigned)(R * K + C) * 2u; voffB[i] = (unsigned)(Rb * K + C) * 2u; }
    const size_t kstep = (size_t)(BK * 2);
    const size_t hstep = (size_t)HALF * K * 2;
    const size_t tstep = 2 * hstep;
    const unsigned ldsw = (unsigned)wid * 1024u;
    const int aoff = lds_byte(wr * 64 + fr, fq * 8), boff = lds_byte(wc * 32 + fr, fq * 8);
#define PG8_SA(b, h) (((b) * 2 + (h)) * HTB)
#define PG8_SB(b, h) ((4 + (b) * 2 + (h)) * HTB)
#define PG8_STAGE(bufoff, gbase, voff) do { _Pragma("unroll") for (int _i = 0; _i < 2; ++_i) \
        __builtin_amdgcn_global_load_lds((const unsigned*)((const char*)(gbase) + (voff)[_i]), (PG8_LAS unsigned*)(lds + (bufoff) + ldsw + _i * 8192), 16, 0, 0); } while (0)
#define PG8_LDA(dst, b, h) do { _Pragma("unroll") for (int m = 0; m < 4; ++m) _Pragma("unroll") for (int k = 0; k < 2; ++k) dst[m][k] = *(const PG8_LAS bf16x8*)(lds + PG8_SA(b, h) + aoff + m * 2048 + k * 1024); } while (0)
#define PG8_LDB(dst, b, h) do { _Pragma("unroll") for (int n = 0; n < 2; ++n) _Pragma("unroll") for (int k = 0; k < 2; ++k) dst[n][k] = *(const PG8_LAS bf16x8*)(lds + PG8_SB(b, h) + boff + n * 2048 + k * 1024); } while (0)
#define PG8_MMA(ai, bj, At, Bt) do { __builtin_amdgcn_s_setprio(1); _Pragma("unroll") for (int m = 0; m < 4; ++m) _Pragma("unroll") for (int n = 0; n < 2; ++n) _Pragma("unroll") for (int k = 0; k < 2; ++k) \
        acc[ai][bj][m][n] = __builtin_amdgcn_mfma_f32_16x16x32_bf16(Bt[n][k], At[m][k], acc[ai][bj][m][n], 0, 0, 0); __builtin_amdgcn_s_setprio(0); } while (0)
#define PG8_WAIT_V(n) asm volatile("s_waitcnt vmcnt(" #n ")" ::: "memory")
#define PG8_WAIT_L(n) asm volatile("s_waitcnt lgkmcnt(" #n ")" ::: "memory")
#define PG8_BAR __builtin_amdgcn_s_barrier()
#define PG8_SCHED __builtin_amdgcn_sched_barrier(0)
    Unit cur, nxt; int ui = 0;
    if (!S.next(0, cur)) return;
    f32x4 acc[2][2][4][2];
#pragma unroll
    for (int a = 0; a < 2; ++a)
#pragma unroll
        for (int b = 0; b < 2; ++b)
#pragma unroll
            for (int m = 0; m < 4; ++m)
#pragma unroll
                for (int n = 0; n < 2; ++n) acc[a][b][m][n] = (f32x4){0.f, 0.f, 0.f, 0.f};
    bf16x8 At[4][2], B0[2][2], B1[2][2];
    const char* cA = (const char*)g.A + (size_t)cur.pm * tstep; const char* cB = (const char*)g.Bt + (size_t)cur.pn * tstep;
    S.a_ready(cur);
    if constexpr (SP2) {
        PG8_STAGE(PG8_SB(0, 0), cB, voffB); PG8_STAGE(PG8_SB(0, 1), cB + hstep, voffB); PG8_STAGE(PG8_SA(0, 0), cA, voffA); PG8_STAGE(PG8_SA(0, 1), cA + hstep, voffA);
        if (wr == 1) PG8_BAR;
        PG8_WAIT_V(2); PG8_BAR;
        PG8_STAGE(PG8_SB(1, 0), cB + kstep, voffB); PG8_STAGE(PG8_SA(1, 0), cA + kstep, voffA); PG8_STAGE(PG8_SB(1, 1), cB + hstep + kstep, voffB);
        PG8_WAIT_V(6); PG8_BAR;
    } else {
        PG8_STAGE(PG8_SB(0, 0), cB, voffB); PG8_STAGE(PG8_SA(0, 0), cA, voffA); PG8_STAGE(PG8_SB(0, 1), cB + hstep, voffB); PG8_STAGE(PG8_SA(0, 1), cA + hstep, voffA);
        if (wr == 1) PG8_BAR;
        PG8_WAIT_V(4); PG8_BAR;
        PG8_STAGE(PG8_SB(1, 0), cB + kstep, voffB); PG8_STAGE(PG8_SA(1, 0), cA + kstep, voffA); PG8_STAGE(PG8_SB(1, 1), cB + hstep + kstep, voffB);
        PG8_WAIT_V(6); PG8_BAR;
    }
    for (;;) {
        const bool has_next = S.next(ui + 1, nxt);
        const char* nA = has_next ? (const char*)g.A + (size_t)nxt.pm * tstep : cA; const char* nB = has_next ? (const char*)g.Bt + (size_t)nxt.pn * tstep : cB;
        for (int t = 0; t < nt; t += 2) {
            const bool last = (t == nt - 2);
            const char* a1 = cA + (size_t)(t + 1) * kstep;
            const char* a2 = last ? nA : cA + (size_t)(t + 2) * kstep; const char* b2 = last ? nB : cB + (size_t)(t + 2) * kstep;
            const char* a3 = a2 + kstep; const char* b3 = b2 + kstep;
            if (last && has_next) S.a_ready(nxt);
            if constexpr (SP2) {
            PG8_LDB(B0, 0, 0); PG8_LDB(B1, 0, 1); PG8_SCHED; PG8_LDA(At, 0, 0); PG8_STAGE(PG8_SA(1, 1), a1 + hstep, voffA);
            PG8_WAIT_V(8); PG8_WAIT_L(0); PG8_BAR; PG8_MMA(0, 0, At, B0); PG8_MMA(0, 1, At, B1); PG8_BAR; PG8_SCHED;
            PG8_LDA(At, 0, 1); PG8_STAGE(PG8_SB(0, 0), b2, voffB); PG8_STAGE(PG8_SB(0, 1), b2 + hstep, voffB); PG8_STAGE(PG8_SA(0, 0), a2, voffA);
            PG8_WAIT_V(8); PG8_WAIT_L(0); PG8_BAR; PG8_MMA(1, 0, At, B0); PG8_MMA(1, 1, At, B1); PG8_BAR; PG8_SCHED;
            PG8_LDB(B0, 1, 0); PG8_LDB(B1, 1, 1); PG8_SCHED; PG8_LDA(At, 1, 0); PG8_STAGE(PG8_SA(0, 1), a2 + hstep, voffA);
            PG8_WAIT_V(8); PG8_WAIT_L(0); PG8_BAR; PG8_MMA(0, 0, At, B0); PG8_MMA(0, 1, At, B1); PG8_BAR; PG8_SCHED;
            PG8_LDA(At, 1, 1); PG8_STAGE(PG8_SB(1, 0), b3, voffB); PG8_STAGE(PG8_SB(1, 1), b3 + hstep, voffB); PG8_STAGE(PG8_SA(1, 0), a3, voffA);
            PG8_WAIT_V(8); PG8_WAIT_L(0); PG8_BAR; PG8_MMA(1, 0, At, B0); PG8_MMA(1, 1, At, B1); PG8_BAR; PG8_SCHED;
            } else {
            PG8_LDB(B0, 0, 0); PG8_SCHED; PG8_LDA(At, 0, 0); PG8_STAGE(PG8_SA(1, 1), a1 + hstep, voffA);
            PG8_WAIT_L(8); PG8_BAR; PG8_WAIT_L(0); PG8_MMA(0, 0, At, B0); PG8_BAR; PG8_SCHED;
            PG8_LDB(B1, 0, 1); PG8_STAGE(PG8_SB(0, 0), b2, voffB);
            PG8_BAR; PG8_WAIT_L(0); PG8_MMA(0, 1, At, B1); PG8_BAR;
            PG8_LDA(At, 0, 1); PG8_STAGE(PG8_SA(0, 0), a2, voffA);
            PG8_BAR; PG8_WAIT_L(0); PG8_MMA(1, 0, At, B0); PG8_BAR; PG8_SCHED;
            PG8_STAGE(PG8_SB(0, 1), b2 + hstep, voffB);
            PG8_WAIT_V(6); PG8_BAR; PG8_MMA(1, 1, At, B1); PG8_BAR;
            PG8_LDB(B0, 1, 0); PG8_SCHED; PG8_LDA(At, 1, 0); PG8_STAGE(PG8_SA(0, 1), a2 + hstep, voffA);
            PG8_WAIT_L(8); PG8_BAR; PG8_WAIT_L(0); PG8_MMA(0, 0, At, B0); PG8_BAR; PG8_SCHED;
            PG8_LDB(B1, 1, 1); PG8_STAGE(PG8_SB(1, 0), b3, voffB);
            PG8_BAR; PG8_WAIT_L(0); PG8_MMA(0, 1, At, B1); PG8_BAR;
            PG8_LDA(At, 1, 1); PG8_STAGE(PG8_SA(1, 0), a3, voffA);
            PG8_BAR; PG8_WAIT_L(0); PG8_MMA(1, 0, At, B0); PG8_BAR; PG8_SCHED;
            PG8_STAGE(PG8_SB(1, 1), b3 + hstep, voffB);
            PG8_WAIT_V(6); PG8_BAR; PG8_MMA(1, 1, At, B1); PG8_BAR;
            }
        }
        if constexpr (ALIGN_EPI) { if (wr == 0) PG8_BAR; }
        if constexpr (!Epi::AFTER_DRAIN) { E(acc, cur, wr, wc, fr, fq); S.done(cur); }
        if (!has_next) break;
#pragma unroll
        for (int a = 0; a < 2; ++a)
#pragma unroll
            for (int b = 0; b < 2; ++b)
#pragma unroll
                for (int m = 0; m < 4; ++m)
#pragma unroll
                    for (int n = 0; n < 2; ++n) acc[a][b][m][n] = (f32x4){0.f, 0.f, 0.f, 0.f};
        cur = nxt; cA = nA; cB = nB; ++ui;
        if constexpr (ALIGN_EPI) { if (wr == 1) PG8_BAR; }
    }
    PG8_WAIT_V(0);
    if constexpr (!ALIGN_EPI) { if (wr == 0) PG8_BAR; }
    PG8_BAR;
    if constexpr (Epi::AFTER_DRAIN) { E.fused(acc, cur, wr, wc, fr, fq, lds, wid, lane); S.done(cur); }
#undef PG8_SA
#undef PG8_SB
#undef PG8_STAGE
#undef PG8_LDA
#undef PG8_LDB
#undef PG8_MMA
#undef PG8_WAIT_V
#undef PG8_WAIT_L
#undef PG8_BAR
#undef PG8_SCHED
}
}

#ifndef PG8_SP2
#define PG8_SP2 true
#endif
#ifndef PG8_ALIGN
#define PG8_ALIGN true
#endif
constexpr int NB = 8, SEQ = 8192, DM = 1024, FF = 4096, M = NB * SEQ;
constexpr int AH = 16, AKV = 4, AHD = 64, A_IN = 1536;
constexpr int GH = 4, GDK = 128, GDV = 256, G_IN = 3104, G_INP = 3328, GQK = 512, GVC = 1024;
constexpr float LN_EPS = 1e-5f, HN_EPS = 1e-6f;
constexpr float DN_ALPHA = 1.41421356237309515f;
constexpr float LOG2E = 1.4426950408889634f;
constexpr int NWAVES = 8, NTHREADS = 512;
constexpr size_t MiB = 1u << 20;
constexpr size_t WS_CTL = 0, CTL_ZERO_BYTES = 2 * MiB;
constexpr size_t WS_FOLD = 32 * 1024;
constexpr size_t WS_ST4 = 13 * MiB + 512 * 1024;
constexpr size_t WS_ST1 = 512 * 1024, WS_ST2 = 1024 * 1024, WS_ST3 = 1536 * 1024;
constexpr size_t WS_WAIN = 2 * MiB, WS_WAOUT = 5 * MiB, WS_WGIN = 7 * MiB, WS_WGOUT = 14 * MiB, WS_W1 = 16 * MiB, WS_W2 = 32 * MiB;
constexpr size_t WS_COS = 48 * MiB, WS_SIN = 56 * MiB;
constexpr size_t WS_LR = 48 * MiB, WS_DL = 56 * MiB;
constexpr size_t WS_ATT = 64 * MiB;
constexpr size_t WS_XB = 128 * MiB;
constexpr size_t WS_R = 512 * MiB;
constexpr size_t WS_Q = WS_R, WS_K = WS_R + 128 * MiB, WS_V = WS_R + 160 * MiB, WS_O = WS_R + 192 * MiB;
constexpr size_t WS_GQ = WS_R, WS_GK = WS_R + 64 * MiB, WS_GV = WS_R + 128 * MiB, WS_GR = WS_R + 256 * MiB, WS_QEB = WS_R + 384 * MiB, WS_KDB = WS_R + 448 * MiB;
constexpr size_t WS_END = 1024 * MiB;
constexpr int MISC_OFF = 147456;
constexpr int LDS_BYTES = 147456 + 256;

#define GAS __attribute__((address_space(1)))
#define LAS __attribute__((address_space(3)))
typedef unsigned short bf16;
typedef unsigned v4u __attribute__((ext_vector_type(4)));
typedef unsigned v2u __attribute__((ext_vector_type(2)));
typedef float f32x4 __attribute__((ext_vector_type(4)));
typedef float f32x2 __attribute__((ext_vector_type(2)));
typedef short bf16x8 __attribute__((ext_vector_type(8)));
#define DI __device__ __forceinline__
DI unsigned f2bf(float f) { unsigned u = __builtin_bit_cast(unsigned, f); return (u + 0x7fffu + ((u >> 16) & 1u)) >> 16; }
DI unsigned pk2(float lo, float hi) { return f2bf(lo) | (f2bf(hi) << 16); }
DI float bf2f(unsigned short h) { return __builtin_bit_cast(float, (unsigned)h << 16); }
DI float bflo(unsigned w) { return __builtin_bit_cast(float, w << 16); }
DI float bfhi(unsigned w) { return __builtin_bit_cast(float, w & 0xffff0000u); }
DI float wave_sum(float v) {
#pragma unroll
    for (int o = 1; o < 64; o <<= 1) v += __shfl_xor(v, o);
    return v;
}

DI int rope_dest(int c) { const int hh = c >> 6, dd = c & 63, n = dd >> 5, d1 = dd & 31; return (hh << 6) + 8 * (d1 >> 2) + 4 * n + (d1 & 3); }
DI int hid_perm(int c) { return (c & ~255) + 64 * ((c >> 5) & 3) + 32 * ((c >> 7) & 1) + (c & 31); }
DI void p0_transpose_item(const float* W, int K, int N, bf16* WT, int rope_cols, LAS float* scr, int item, int lane, const float* gv = nullptr, const float* bv = nullptr, float* cs = nullptr, float* cb = nullptr, bool hperm = false) {
    const int nblk = N / 32, kb = item / nblk, nb = item % nblk, k0 = 64 * kb, n0 = 32 * nb;
    float csp = 0.f, cbp = 0.f;
#pragma unroll 8
    for (int i = 0; i < 32; ++i) { const int kk = 2 * i + (lane >> 5); float w = W[(size_t)(k0 + kk) * N + n0 + (lane & 31)];
        if (gv) { cbp += bv[k0 + kk] * w; w *= gv[k0 + kk]; csp += __builtin_bit_cast(float, f2bf(w) << 16); }
        scr[kk * 33 + (lane & 31)] = w; }
    if (gv) { __hip_atomic_fetch_add(cs + n0 + (lane & 31), csp, __ATOMIC_RELAXED, __HIP_MEMORY_SCOPE_AGENT); __hip_atomic_fetch_add(cb + n0 + (lane & 31), cbp, __ATOMIC_RELAXED, __HIP_MEMORY_SCOPE_AGENT); }
    asm volatile("s_waitcnt lgkmcnt(0)" ::: "memory");
    const int c = lane & 7;
#pragma unroll
    for (int j = 0; j < 4; ++j) { const int n = (lane >> 3) + 8 * j; const LAS float* s = scr + (8 * c) * 33 + n;
        v4u o; o.x = pk2(s[0 * 33], s[1 * 33]); o.y = pk2(s[2 * 33], s[3 * 33]); o.z = pk2(s[4 * 33], s[5 * 33]); o.w = pk2(s[6 * 33], s[7 * 33]);
        const int col = n0 + n; const int drow = col < rope_cols ? rope_dest(col) : col;
        const int kd = hperm ? hid_perm(k0 + 8 * c) : k0 + 8 * c;
        *(v4u*)(WT + (size_t)drow * K + kd) = o; }
    asm volatile("s_waitcnt lgkmcnt(0)" ::: "memory");
}
struct Args { const float* in[18]; float* out; unsigned char* ws; int ph_lo, ph_hi; };

DI void p0_prologue(const Args& a, LAS unsigned char* lds, int gw, int NGW, int wave, int lane) {
    LAS float* scr = (LAS float*)(lds + wave * 16384);
    unsigned char* ws = a.ws;
    constexpr int I_AIN = (DM / 64) * (A_IN / 32), I_SQ = (DM / 64) * (DM / 32), I_GIN = (DM / 64) * (G_IN / 32), I_1 = (DM / 64) * (FF / 32), I_2 = (FF / 64) * (DM / 32);
    constexpr int NITEMS = I_AIN + 2 * I_SQ + I_GIN + 2 * I_1 + 2 * I_2;
    for (int it = gw; it < NITEMS; it += NGW) {
        int r = it;
        if (r < I_AIN) { p0_transpose_item(a.in[2], DM, A_IN, (bf16*)(ws + WS_WAIN), 1280, scr, r, lane); continue; } r -= I_AIN;
        if (r < I_SQ) { p0_transpose_item(a.in[4], DM, DM, (bf16*)(ws + WS_WAOUT), 0, scr, r, lane); continue; } r -= I_SQ;
        if (r < I_GIN) { p0_transpose_item(a.in[5], DM, G_IN, (bf16*)(ws + WS_WGIN), 0, scr, r, lane, a.in[16], a.in[17], (float*)(ws + WS_FOLD + 32768), (float*)(ws + WS_FOLD + 49152)); continue; } r -= I_GIN;
        if (r < I_SQ) { p0_transpose_item(a.in[11], DM, DM, (bf16*)(ws + WS_WGOUT), 0, scr, r, lane); continue; } r -= I_SQ;
        if (r < 2 * I_1) { const int l = r / I_1; p0_transpose_item(a.in[14] + (size_t)l * DM * FF, DM, FF, (bf16*)(ws + WS_W1 + l * 8 * MiB), 0, scr, r % I_1, lane, a.in[12] + l * DM, a.in[13] + l * DM, (float*)(ws + WS_FOLD + (l ? 65536 : 0)), (float*)(ws + WS_FOLD + (l ? 81920 : 16384))); continue; } r -= 2 * I_1;
        { const int l = r / I_2; p0_transpose_item(a.in[15] + (size_t)l * DM * FF, FF, DM, (bf16*)(ws + WS_W2 + l * 8 * MiB), 0, scr, r % I_2, lane, nullptr, nullptr, nullptr, nullptr, true); }
    }
    { v4u* z = (v4u*)(ws + WS_WGIN + (size_t)G_IN * DM * 2); const int n16 = (G_INP - G_IN) * DM * 2 / 16;
      for (int i = gw * 64 + lane; i < n16; i += NGW * 64) z[i] = (v4u){0u, 0u, 0u, 0u}; }
    { const f32x4* x4 = (const f32x4*)a.in[0]; v2u* o = (v2u*)(ws + WS_XB); const int n4 = M * DM / 4, step = NGW * 64;
      for (int i = gw * 64 + lane; i < n4; i += 8 * step) { f32x4 v[8];
#pragma unroll
          for (int k = 0; k < 8; ++k) v[k] = x4[(i + k * step < n4) ? i + k * step : i];
#pragma unroll
          for (int k = 0; k < 8; ++k) if (i + k * step < n4) o[i + k * step] = (v2u){pk2(v[k].x, v[k].y), pk2(v[k].z, v[k].w)}; } }
    { f32x4* z4 = (f32x4*)(ws + WS_ST4); for (int i = gw * 64 + lane; i < M * 2 / 4; i += NGW * 64) z4[i] = (f32x4){0.f, 0.f, 0.f, 0.f}; }
    { const int* pos = (const int*)a.in[1]; float* ct = (float*)(ws + WS_COS); float* st = (float*)(ws + WS_SIN);
      for (int i = gw * 64 + lane; i < M * 32; i += NGW * 64) { const int row = i >> 5, f = i & 31;
          const float inv = (float)exp(-(double)f * (9.210340371976184 / 32.0));
          const float ang = (float)pos[row] * inv;
          const double ad = (double)ang; const double k = rint(ad * 0.15915494309189535); const float r = (float)(ad - k * 6.283185307179586);
          ct[i] = cosf(r); st[i] = sinf(r); } }
}

DI void ln_final_pass(const bf16* ZB, const float* ST, const float* g, const float* b, float* out, int gw, int NGW, int lane) {
    f32x4 gv[2][2], bv[2][2];
#pragma unroll
    for (int j = 0; j < 2; ++j)
#pragma unroll
        for (int n = 0; n < 2; ++n) { gv[j][n] = *(const f32x4*)(g + 8 * lane + 512 * j + 4 * n); bv[j][n] = *(const f32x4*)(b + 8 * lane + 512 * j + 4 * n); }
    for (int m = 4 * gw; m < M; m += 4 * NGW) {
        v4u v[4][2]; f32x2 st[4];
#pragma unroll
        for (int r = 0; r < 4; ++r) { st[r] = *(const f32x2*)(ST + 2 * (size_t)(m + r));
#pragma unroll
            for (int j = 0; j < 2; ++j) v[r][j] = *(const v4u*)(ZB + (size_t)(m + r) * DM + 8 * lane + 512 * j); }
#pragma unroll
        for (int r = 0; r < 4; ++r) { const float mean = st[r].x * (1.f / DM), rstd = __builtin_amdgcn_rsqf(st[r].y * (1.f / DM) - mean * mean + LN_EPS);
#pragma unroll
            for (int j = 0; j < 2; ++j) { const v4u w = v[r][j];
                const f32x4 x0 = {bflo(w.x), bfhi(w.x), bflo(w.y), bfhi(w.y)}, x1 = {bflo(w.z), bfhi(w.z), bflo(w.w), bfhi(w.w)};
                float* o = out + (size_t)(m + r) * DM + 8 * lane + 512 * j;
                *(f32x4*)o = (x0 - mean) * rstd * gv[j][0] + bv[j][0]; *(f32x4*)(o + 4) = (x1 - mean) * rstd * gv[j][1] + bv[j][1]; } }
    }
}

DI void gla_norm_pass(const bf16* OF, const bf16* OB, const bf16* Gr, const float* ng, bf16* Y, int gw, int NGW, int lane) {
    float g16[16];
#pragma unroll
    for (int i = 0; i < 16; ++i) g16[i] = ng[(lane & 15) * 16 + i];
    v4u a0, a1, b0, b1, r0, r1;
#define GN_LOAD(m_) do { const size_t off_ = (size_t)(m_) * GVC + lane * 16; a0 = *(const v4u*)(OF + off_); a1 = *(const v4u*)(OF + off_ + 8); b0 = *(const v4u*)(OB + off_); b1 = *(const v4u*)(OB + off_ + 8); r0 = *(const v4u*)(Gr + off_); r1 = *(const v4u*)(Gr + off_ + 8); } while (0)
    if (gw < M) GN_LOAD(gw);
    for (int m = gw; m < M; m += NGW) {
        const size_t off = (size_t)m * GVC + lane * 16;
        float o[16], r[16];
        const unsigned aw[8] = {a0.x, a0.y, a0.z, a0.w, a1.x, a1.y, a1.z, a1.w}, bw[8] = {b0.x, b0.y, b0.z, b0.w, b1.x, b1.y, b1.z, b1.w}, rw[8] = {r0.x, r0.y, r0.z, r0.w, r1.x, r1.y, r1.z, r1.w};
        { const int mn = (m + NGW < M) ? m + NGW : m; GN_LOAD(mn); }
        float ss = 0.f;
#pragma unroll
        for (int i = 0; i < 8; ++i) { o[2 * i] = bflo(aw[i]) + bflo(bw[i]); o[2 * i + 1] = bfhi(aw[i]) + bfhi(bw[i]); r[2 * i] = bflo(rw[i]); r[2 * i + 1] = bfhi(rw[i]); ss += o[2 * i] * o[2 * i] + o[2 * i + 1] * o[2 * i + 1]; }
        ss += __shfl_xor(ss, 1); ss += __shfl_xor(ss, 2); ss += __shfl_xor(ss, 4); ss += __shfl_xor(ss, 8);
        const float rs = __builtin_amdgcn_rsqf(ss * (1.f / GDV) + HN_EPS);
        unsigned w[8];
#pragma unroll
        for (int i = 0; i < 8; ++i) { const float x0 = o[2 * i] * rs * g16[2 * i], x1 = o[2 * i + 1] * rs * g16[2 * i + 1];
            const float s0 = r[2 * i] * __builtin_amdgcn_rcpf(1.f + __builtin_amdgcn_exp2f(-r[2 * i] * LOG2E)), s1 = r[2 * i + 1] * __builtin_amdgcn_rcpf(1.f + __builtin_amdgcn_exp2f(-r[2 * i + 1] * LOG2E)); w[i] = pk2(x0 * s0, x1 * s1); }
        *(v4u*)(Y + off) = (v4u){w[0], w[1], w[2], w[3]}; *(v4u*)(Y + off + 8) = (v4u){w[4], w[5], w[6], w[7]};
    }
#undef GN_LOAD
}

#define XB_TMO      128
#define XB_XCNT(j)  (256  + 64 * (j))
#define XB_XSUB(j)  (1280 + 64 * (j))
#define XB_XGEN(j)  (2304 + 64 * (j))
#define XB_TOP      3328
#define XB_TOPGEN   3392
#define XCD_BAR_WORDS 3456
#define XB_SPIN_CAP (1u << 18)

__device__ __forceinline__ unsigned xb_ld(unsigned* p)              { return __hip_atomic_load(p, __ATOMIC_RELAXED, __HIP_MEMORY_SCOPE_AGENT); }
__device__ __forceinline__ unsigned xb_add(unsigned* p, unsigned v) { return __hip_atomic_fetch_add(p, v, __ATOMIC_RELAXED, __HIP_MEMORY_SCOPE_AGENT); }
__device__ __forceinline__ unsigned xb_xcc_id() { return (unsigned)__builtin_amdgcn_s_getreg((3 << 11) | 20) & 0xFu; }
#define XB_SPIN(cond, bar) do { unsigned _sp = 0; while (cond) { __builtin_amdgcn_s_sleep(1); \
    if ((++_sp & 255u) == 0u) { if (xb_ld(&(bar)[XB_TMO])) break; if (_sp > XB_SPIN_CAP) { atomicAdd(&(bar)[XB_TMO], 1u); break; } } } } while (0)

struct XcdBarrier {
    unsigned* bar; unsigned x;
    volatile LAS unsigned* st;
};

__device__ __forceinline__ XcdBarrier xcd_barrier_post(unsigned* bar, volatile LAS unsigned* st) {
    XcdBarrier b; b.bar = bar; b.x = xb_xcc_id(); b.st = st;
    if (threadIdx.x == 0) (void)xb_add(&bar[XB_XCNT(b.x)], 1u);
    return b;
}
__device__ __forceinline__ void xcd_barrier_complete(unsigned* bar, unsigned x, unsigned& nloc, unsigned& nx) {
    const unsigned G = gridDim.x * gridDim.y * gridDim.z;
    unsigned sum, cnt, mine, sp = 0u;
    for (;;) {
        sum = 0u; cnt = 0u; mine = 0u;
#pragma unroll
        for (unsigned j = 0; j < 16; ++j) { const unsigned c = xb_ld(&bar[XB_XCNT(j)]); sum += c; cnt += (c > 0u) ? 1u : 0u; mine = (j == x) ? c : mine; }
        if (sum == G) break;
        __builtin_amdgcn_s_sleep(1);
        if ((++sp & 255u) == 0u) { if (xb_ld(&bar[XB_TMO])) break; if (sp > XB_SPIN_CAP) { atomicAdd(&bar[XB_TMO], 1u); break; } }
    }
    nloc = mine > 0u ? mine : 1u; nx = cnt > 0u ? cnt : 1u;
}

__device__ __forceinline__ void xcd_barrier(const XcdBarrier& b) {
    asm volatile("s_waitcnt vmcnt(0)" ::: "memory");
    __syncthreads();
    if (threadIdx.x == 0) {
        unsigned* bar = b.bar;
        __builtin_amdgcn_s_waitcnt(0);
        unsigned nloc = b.st[0], nx = b.st[1];
        if (nloc == 0u) { xcd_barrier_complete(bar, b.x, nloc, nx); b.st[0] = nloc; b.st[1] = nx; }
        const unsigned old = xb_add(&bar[XB_XSUB(b.x)], 1u);
        const unsigned gen = old / nloc;
        if (old + 1u == (gen + 1u) * nloc) {
            __builtin_amdgcn_fence(__ATOMIC_RELEASE, "agent");
            asm volatile("s_waitcnt vmcnt(0)" ::: "memory");
            const unsigned og = xb_add(&bar[XB_TOP], 1u);
            const unsigned tg = og / nx;
            if (og + 1u == (tg + 1u) * nx) xb_add(&bar[XB_TOPGEN], 1u);
            else XB_SPIN(xb_ld(&bar[XB_TOPGEN]) == tg, bar);
            __builtin_amdgcn_fence(__ATOMIC_ACQUIRE, "agent");
            xb_add(&bar[XB_XGEN(b.x)], 1u);
            asm volatile("s_waitcnt vmcnt(0)" ::: "memory");
        } else {
            XB_SPIN(xb_ld(&bar[XB_XGEN(b.x)]) == gen, bar);
            __builtin_amdgcn_fence(__ATOMIC_ACQUIRE, "agent");
            asm volatile("s_waitcnt vmcnt(0)" ::: "memory");
        }
    }
    __syncthreads();
}
typedef float f32x16 __attribute__((ext_vector_type(16)));
typedef short s16x4 __attribute__((ext_vector_type(4)));
typedef __bf16 bf16x2_t __attribute__((ext_vector_type(2)));
DI unsigned cvtpk(float lo, float hi) { f32x2 v = {lo, hi}; bf16x2_t b = __builtin_convertvector(v, bf16x2_t); return __builtin_bit_cast(unsigned, b); }
DI s16x4 tr_read(const LAS unsigned char* p) { return __builtin_bit_cast(s16x4, __builtin_amdgcn_ds_read_tr16_b64_v4i16((LAS s16x4*)p)); }
DI int crow(int reg, int h) { return (reg & 3) + 8 * (reg >> 2) + 4 * h; }
DI bf16x8 pack_step(const f32x16& x, int s) { v4u p; p.x = cvtpk(x[8 * s], x[8 * s + 1]); p.y = cvtpk(x[8 * s + 2], x[8 * s + 3]); p.z = cvtpk(x[8 * s + 4], x[8 * s + 5]); p.w = cvtpk(x[8 * s + 6], x[8 * s + 7]); return __builtin_bit_cast(bf16x8, p); }
#define MFMA32(a, b, c) __builtin_amdgcn_mfma_f32_32x32x16_bf16((a), (b), (c), 0, 0, 0)
#define MFMA16(a, b, c) __builtin_amdgcn_mfma_f32_16x16x32_bf16((a), (b), (c), 0, 0, 0)
constexpr int ATT_KP = 144, ATT_VP = 144, ATT_V_OFF = 512 * ATT_KP;
static_assert(ATT_V_OFF + 512 * ATT_VP <= 147456, "attention LDS");

DI void attn_mfma(const bf16* Q, const bf16* Kb, const bf16* Vb, bf16* O, const float* sink, LAS unsigned char* lds, int blk, int G, int tid) {
    const int lane = tid & 63, wave = __builtin_amdgcn_readfirstlane(tid >> 6), r32 = lane & 31, h = lane >> 5, i16 = lane & 15, blk16 = (lane >> 4) & 1;
    const int hl = wave >> 1, qloc = (wave & 1) * 64;
    const int vblk = (G % 8 == 0) ? (blk % 8) * (G / 8) + blk / 8 : blk;
    for (int run = vblk; run < NB * AKV * 8; run += G) {
        const int b = run >> 5, kvh = (run >> 3) & 3, qb0 = (run & 7) * 8;
        const int head = kvh * 4 + hl;
        const bf16* Kg = Kb + (size_t)b * SEQ * 256 + kvh * 64; const bf16* Vg = Vb + (size_t)b * SEQ * 256 + kvh * 64;
        __syncthreads();
#pragma unroll
        for (int i = 0; i < 6; ++i) { const int c = tid + 512 * i, r = c >> 3, ch = c & 7, kpos = 128 * (qb0 - 1) + r;
            v4u kv = {0u, 0u, 0u, 0u}, vv = {0u, 0u, 0u, 0u};
            if (kpos >= 0 && kpos < SEQ) { kv = *(const v4u*)(Kg + (size_t)kpos * 256 + ch * 8); vv = *(const v4u*)(Vg + (size_t)kpos * 256 + ch * 8); }
            *(LAS v4u*)(lds + (kpos & 511) * ATT_KP + ch * 16) = kv; *(LAS v4u*)(lds + ATT_V_OFF + (kpos & 511) * ATT_VP + ch * 16) = vv; }
        bf16x8 qf[2][4];
        { const size_t qrow0 = (size_t)b * SEQ + qb0 * 128 + qloc;
#pragma unroll
          for (int q2 = 0; q2 < 2; ++q2)
#pragma unroll
              for (int ks = 0; ks < 4; ++ks) qf[q2][ks] = *(const bf16x8*)(Q + (qrow0 + 32 * q2 + r32) * 1024 + head * 64 + 16 * ks + 8 * h); }
        const float m0 = sink[head] * LOG2E;
        __syncthreads();
        for (int j = 0; j < 8; ++j) {
            const int qb = qb0 + j; const int qp0 = qb * 128 + qloc; const size_t qrow0 = (size_t)b * SEQ + qp0;
            v4u pk[2], pv[2]; bf16x8 qn[2][4];
            const int nk0 = 128 * (qb + 2); const bool pf = (j < 7) && (nk0 < SEQ);
#pragma unroll
            for (int i = 0; i < 2; ++i) { const int c = tid + 512 * i, r = c >> 3, ch = c & 7; const int kpos = pf ? nk0 + r : 0;
                pk[i] = *(const v4u*)(Kg + (size_t)kpos * 256 + ch * 8); pv[i] = *(const v4u*)(Vg + (size_t)kpos * 256 + ch * 8); }
            { const size_t qrn = (j < 7) ? qrow0 + 128 : qrow0;
#pragma unroll
              for (int q2 = 0; q2 < 2; ++q2)
#pragma unroll
                  for (int ks = 0; ks < 4; ++ks) qn[q2][ks] = *(const bf16x8*)(Q + (qrn + 32 * q2 + r32) * 1024 + head * 64 + 16 * ks + 8 * h); }
            f32x16 oT[2][2];
#pragma unroll
            for (int a = 0; a < 2; ++a)
#pragma unroll
                for (int c = 0; c < 2; ++c)
#pragma unroll
                    for (int i = 0; i < 16; ++i) oT[a][c][i] = 0.f;
            float mrun[2] = {m0, m0}; float lrun[2]; lrun[0] = lrun[1] = (h == 0) ? 1.f : 0.f;
            for (int kt = 0; kt < 10; ++kt) {
                const int kp0 = qp0 - 128 + 32 * kt, kr0 = kp0 & 511;
                bf16x8 kf[4];
#pragma unroll
                for (int ks = 0; ks < 4; ++ks) kf[ks] = *(const LAS bf16x8*)(lds + (kr0 + r32) * ATT_KP + (16 * ks + 8 * h) * 2);
                f32x16 sT[2];
#pragma unroll
                for (int q2 = 0; q2 < 2; ++q2) {
#pragma unroll
                    for (int i = 0; i < 16; ++i) sT[q2][i] = 0.f;
                }
                __builtin_amdgcn_s_setprio(1);
#pragma unroll
                for (int ks = 0; ks < 4; ++ks) { sT[0] = MFMA32(kf[ks], qf[0][ks], sT[0]); sT[1] = MFMA32(kf[ks], qf[1][ks], sT[1]); }
                __builtin_amdgcn_s_setprio(0);
                const bool full = (kp0 >= 0) && (kp0 + 31 < SEQ) && (qp0 + 63 - kp0 <= 128) && (kp0 + 31 - qp0 <= 128);
                if (!full) {
#pragma unroll
                    for (int q2 = 0; q2 < 2; ++q2) { const int qpos = qp0 + 32 * q2 + r32;
#pragma unroll
                        for (int i = 0; i < 16; ++i) { const int kpos = kp0 + crow(i, h), dl = qpos - kpos; if (kpos < 0 || kpos >= SEQ || dl > 128 || dl < -128) sT[q2][i] = -INFINITY; } }
                }
#pragma unroll
                for (int q2 = 0; q2 < 2; ++q2) {
                    float mx = sT[q2][0];
#pragma unroll
                    for (int i = 1; i < 16; ++i) mx = fmaxf(mx, sT[q2][i]);
                    mx = fmaxf(mx, __shfl_xor(mx, 32));
                    float mref = mrun[q2];
                    if (__any(mx > mref + 6.f)) { const float mn = fmaxf(mref, mx), corr = __builtin_amdgcn_exp2f(mref - mn); mrun[q2] = mn; mref = mn; lrun[q2] *= corr;
#pragma unroll
                        for (int db = 0; db < 2; ++db)
#pragma unroll
                            for (int i = 0; i < 16; ++i) oT[db][q2][i] *= corr; }
                    float ps = 0.f;
#pragma unroll
                    for (int i = 0; i < 16; ++i) { const float p = __builtin_amdgcn_exp2f(sT[q2][i] - mref); sT[q2][i] = p; ps += p; }
                    lrun[q2] += ps;
                }
#pragma unroll
                for (int s = 0; s < 2; ++s) {
                    bf16x8 pf2[2]; pf2[0] = pack_step(sT[0], s); pf2[1] = pack_step(sT[1], s);
#pragma unroll
                    for (int db = 0; db < 2; ++db) {
                        const LAS unsigned char* vp = lds + ATT_V_OFF + (kr0 + 16 * s + 4 * h + (i16 >> 2)) * ATT_VP + (32 * db + 16 * blk16 + 4 * (i16 & 3)) * 2;
                        const s16x4 lo = tr_read(vp), hi = tr_read(vp + 8 * ATT_VP);
                        const bf16x8 vf = __builtin_shufflevector(lo, hi, 0, 1, 2, 3, 4, 5, 6, 7);
                        __builtin_amdgcn_s_setprio(1);
                        oT[db][0] = MFMA32(vf, pf2[0], oT[db][0]); oT[db][1] = MFMA32(vf, pf2[1], oT[db][1]);
                        __builtin_amdgcn_s_setprio(0);
                    }
                }
            }
#pragma unroll
            for (int q2 = 0; q2 < 2; ++q2) { const float lt = lrun[q2] + __shfl_xor(lrun[q2], 32), rl = 1.f / lt;
                bf16* op = O + (qrow0 + 32 * q2 + r32) * 1024 + head * 64 + 4 * h;
#pragma unroll
                for (int db = 0; db < 2; ++db)
#pragma unroll
                    for (int g4 = 0; g4 < 4; ++g4) *(v2u*)(op + 32 * db + 8 * g4) = (v2u){cvtpk(oT[db][q2][4 * g4] * rl, oT[db][q2][4 * g4 + 1] * rl), cvtpk(oT[db][q2][4 * g4 + 2] * rl, oT[db][q2][4 * g4 + 3] * rl)}; }
            if (j < 7) {
#pragma unroll
                for (int i = 0; i < 2; ++i) { const int c = tid + 512 * i, r = c >> 3, ch = c & 7; const int lr = (nk0 + r) & 511;
                    *(LAS v4u*)(lds + lr * ATT_KP + ch * 16) = pf ? pk[i] : (v4u){0u, 0u, 0u, 0u}; *(LAS v4u*)(lds + ATT_V_OFF + lr * ATT_VP + ch * 16) = pf ? pv[i] : (v4u){0u, 0u, 0u, 0u}; }
#pragma unroll
                for (int q2 = 0; q2 < 2; ++q2)
#pragma unroll
                    for (int ks = 0; ks < 4; ++ks) qf[q2][ks] = qn[q2][ks];
            }
            __syncthreads();
        }
    }
}
constexpr int GP = 272;
constexpr int ZP = 132;
constexpr int PREP_QE = 0, PREP_KE = 64 * GP, PREP_KD = 2 * 64 * GP, PREP_Q = 3 * 64 * GP, PREP_K = 4 * 64 * GP, PREP_LR = 5 * 64 * GP, PREP_BS = PREP_LR + 64 * 80, PREP_Z = PREP_BS + 4 * 128 * 4, PREP_END = PREP_Z + 64 * ZP * 4;
static_assert(PREP_END <= 147456, "prep LDS");
DI float logsig2(float z) { return fminf(z, 0.f) * LOG2E - __builtin_amdgcn_logf(1.f + __builtin_amdgcn_exp2f(-fabsf(z) * LOG2E)); }
DI unsigned short cvt1(float x) { return (unsigned short)cvtpk(x, 0.f); }
DI void gla_prep(bf16* Gq, bf16* Gk, bf16* QEB, bf16* KDB, const float* LR, const float* w2f, const float* gbf, const float* w2b, const float* gbb, float* DL, bf16* ATT,
                 LAS unsigned char* lds, int blk, int G, int tid) {
    const int lane = tid & 63, wave = __builtin_amdgcn_readfirstlane(tid >> 6), d = tid & 127, tq = tid >> 7, fr = lane & 15, quad = lane >> 4;
    LAS float* bs = (LAS float*)(lds + PREP_BS); LAS float* zb = (LAS float*)(lds + PREP_Z);
    int hcur = -1; bf16x8 w2frag[2];
    for (int it = blk; it < NB * GH * 128; it += G) {
        const int h = it & 3, c = (it >> 2) & 127, b = it >> 9; const size_t row0 = (size_t)b * SEQ + 64 * c;
        const int unit = (b * GH + h) * 128 + c;
        if (h != hcur) {
#pragma unroll
            for (int dir = 0; dir < 2; ++dir) { const float* w2 = dir ? w2b : w2f; v4u p = {0u, 0u, 0u, 0u};
                if ((quad >> 1) == dir) { const int r0 = (quad & 1) * 8; const int col = h * 128 + 16 * wave + fr; float w[8];
#pragma unroll
                    for (int j = 0; j < 8; ++j) w[j] = w2[(r0 + j) * GQK + col];
                    p = (v4u){cvtpk(w[0], w[1]), cvtpk(w[2], w[3]), cvtpk(w[4], w[5]), cvtpk(w[6], w[7])}; }
                w2frag[dir] = __builtin_bit_cast(bf16x8, p); }
            hcur = h;
        }
        __syncthreads();
        { const f32x4 l = ((const f32x4*)(LR + row0 * 32))[tid]; const int r = tid >> 3, cq = tid & 7;
          *(LAS v2u*)(lds + PREP_LR + r * 80 + cq * 8) = (v2u){cvtpk(l.x, l.y), cvtpk(l.z, l.w)}; }
#pragma unroll
        for (int i = 0; i < 2; ++i) { const int p = tid + 512 * i, r = p >> 4, ch = p & 15; const size_t o = (row0 + r) * GQK + h * 128 + ch * 8;
            *(LAS v4u*)(lds + PREP_Q + r * GP + ch * 16) = *(const v4u*)(Gq + o); *(LAS v4u*)(lds + PREP_K + r * GP + ch * 16) = *(const v4u*)(Gk + o); }
        __syncthreads();
#pragma unroll 1
        for (int dir = 0; dir < 2; ++dir) {
            const float bias = (dir ? gbb : gbf)[h * 128 + d];
#pragma unroll
            for (int T = 0; T < 4; ++T) { const bf16x8 lf = *(const LAS bf16x8*)(lds + PREP_LR + (16 * T + fr) * 80 + quad * 16); f32x4 acc = {0.f, 0.f, 0.f, 0.f};
                acc = MFMA16(lf, dir ? w2frag[1] : w2frag[0], acc);
#pragma unroll
                for (int jj = 0; jj < 4; ++jj) zb[(16 * T + 4 * quad + jj) * ZP + 16 * wave + fr] = acc[jj]; }
            __syncthreads();
            float bl[16];
#pragma unroll
            for (int i = 0; i < 16; ++i) bl[i] = logsig2(zb[(16 * tq + i) * ZP + d] + bias) * (1.f / 16.f);
            if (dir == 0) {
#pragma unroll
                for (int i = 1; i < 16; ++i) bl[i] += bl[i - 1];
                bs[tq * 128 + d] = bl[15];
            } else {
#pragma unroll
                for (int i = 14; i >= 0; --i) bl[i] += bl[i + 1];
                bs[tq * 128 + d] = bl[0];
            }
            __syncthreads();
            const float s0 = bs[d], s1 = bs[128 + d], s2 = bs[256 + d], s3 = bs[384 + d]; const float blast = (s0 + s1) + (s2 + s3);
            float pre;
            if (dir == 0) pre = (tq > 0 ? s0 : 0.f) + (tq > 1 ? s1 : 0.f) + (tq > 2 ? s2 : 0.f);
            else pre = (tq < 3 ? s3 : 0.f) + (tq < 2 ? s2 : 0.f) + (tq < 1 ? s1 : 0.f);
            const float elast = __builtin_amdgcn_exp2f(blast);
#pragma unroll
            for (int i = 0; i < 16; ++i) { const int t = 16 * tq + i; const float eb = __builtin_amdgcn_exp2f(pre + bl[i]);
                const float qv = bf2f(*(const LAS unsigned short*)(lds + PREP_Q + t * GP + d * 2)), kv = bf2f(*(const LAS unsigned short*)(lds + PREP_K + t * GP + d * 2));
                const float ke = kv * __builtin_amdgcn_rcpf(eb);
                *(LAS unsigned short*)(lds + PREP_QE + t * GP + d * 2) = cvt1(qv * eb); *(LAS unsigned short*)(lds + PREP_KE + t * GP + d * 2) = cvt1(ke); *(LAS unsigned short*)(lds + PREP_KD + t * GP + d * 2) = cvt1(ke * elast); }
            if (tq == 0) DL[((size_t)dir * (NB * GH * 128) + unit) * 128 + d] = elast;
            __syncthreads();
            { bf16* QEo = dir ? QEB : Gq; bf16* KDo = dir ? KDB : Gk;
#pragma unroll
              for (int i = 0; i < 2; ++i) { const int p = tid + 512 * i, r = p >> 4, ch = p & 15; const size_t o = (row0 + r) * GQK + h * 128 + ch * 8;
                  *(v4u*)(QEo + o) = *(const LAS v4u*)(lds + PREP_QE + r * GP + ch * 16); *(v4u*)(KDo + o) = *(const LAS v4u*)(lds + PREP_KD + r * GP + ch * 16); } }
            const int tt = wave & 3;
            bf16x8 qf[4];
#pragma unroll
            for (int ks = 0; ks < 4; ++ks) qf[ks] = *(const LAS bf16x8*)(lds + PREP_QE + (16 * tt + fr) * GP + (32 * ks + 8 * quad) * 2);
            bf16* attp = ATT + ((size_t)dir * (NB * GH * 128) + unit) * 4096;
#pragma unroll
            for (int j = 0; j < 2; ++j) { const int st = 2 * (wave >> 2) + j; f32x4 acc = {0.f, 0.f, 0.f, 0.f};
#pragma unroll
                for (int ks = 0; ks < 4; ++ks) { const bf16x8 kf = *(const LAS bf16x8*)(lds + PREP_KE + (16 * st + fr) * GP + (32 * ks + 8 * quad) * 2); acc = MFMA16(kf, qf[ks], acc); }
                const int t = 16 * tt + fr, sb = 16 * st + 4 * quad;
#pragma unroll
                for (int jj = 0; jj < 4; ++jj) { const int s = sb + jj; const bool keep = dir ? (s >= t) : (s <= t); if (!keep) acc[jj] = 0.f; }
                *(v2u*)(attp + t * 64 + sb) = (v2u){cvtpk(acc[0], acc[1]), cvtpk(acc[2], acc[3])}; }
            __syncthreads();
        }
    }
}

constexpr int SC_AP = 144, SC_VP = 144;
constexpr int SC_ATT = 0, SC_QE = 64 * SC_AP, SC_KD = SC_QE + 64 * GP, SC_V = SC_KD + 64 * GP, SC_DL = SC_V + 64 * SC_VP, SC_BUF = SC_DL + 512, SC_ST = 2 * SC_BUF, SC_END = SC_ST + 64 * GP;
static_assert(SC_END <= 131072, "scan LDS");
DI void gla_scan(const bf16* QEF, const bf16* QEB, const bf16* KDF, const bf16* KDB, const bf16* Gv, const float* DL, const bf16* ATT, bf16* OF, bf16* OB, LAS unsigned char* lds, int blk, int G, int tid) {
    const int lane = tid & 63, wave = __builtin_amdgcn_readfirstlane(tid >> 6), fr = lane & 15, quad = lane >> 4;
    const int vblk = (G % 8 == 0) ? (blk % 8) * (G / 8) + blk / 8 : blk;
    for (int u = vblk; u < NB * GH * 2 * 4; u += G) {
        const int dvs = u & 3, dir = (u >> 2) & 1, h = (u >> 3) & 3, b = u >> 5;
        const bf16* QE = dir ? QEB : QEF; const bf16* KD = dir ? KDB : KDF; bf16* OUT = dir ? OB : OF;
        const float* DLu = DL + ((size_t)dir * (NB * GH * 128) + (b * GH + h) * 128) * 128; const bf16* ATTu = ATT + ((size_t)dir * (NB * GH * 128) + (b * GH + h) * 128) * 4096;
        f32x4 S[4];
#pragma unroll
        for (int n = 0; n < 4; ++n) S[n] = (f32x4){0.f, 0.f, 0.f, 0.f};
        v4u raA, rqA[2], rkA[2], rvA, rdA, raB, rqB[2], rkB[2], rvB, rdB;
        const int a_r = tid >> 3, a_c = tid & 7;
#define SC_LOAD(X, c_) do { const int cl_ = (c_) < 127 ? (c_) : 127; const int cc_ = dir ? 127 - cl_ : cl_; const size_t row0_ = (size_t)b * SEQ + 64 * cc_; \
            ra##X = *(const v4u*)(ATTu + (size_t)cc_ * 4096 + tid * 8); \
            rv##X = *(const v4u*)(Gv + (row0_ + a_r) * GVC + h * 256 + dvs * 64 + a_c * 8); \
            _Pragma("unroll") for (int i_ = 0; i_ < 2; ++i_) { const int p_ = tid + 512 * i_, r_ = p_ >> 4, c2_ = p_ & 15; \
                rq##X[i_] = *(const v4u*)(QE + (row0_ + r_) * GQK + h * 128 + c2_ * 8); rk##X[i_] = *(const v4u*)(KD + (row0_ + r_) * GQK + h * 128 + c2_ * 8); } \
            rd##X = *(const v4u*)(DLu + (size_t)cc_ * 128 + (tid & 31) * 4); } while (0)
#define SC_STORE(X, bufo) do { *(LAS v4u*)(lds + (bufo) + SC_ATT + a_r * SC_AP + a_c * 16) = ra##X; *(LAS v4u*)(lds + (bufo) + SC_V + a_r * SC_VP + a_c * 16) = rv##X; \
            _Pragma("unroll") for (int i_ = 0; i_ < 2; ++i_) { const int p_ = tid + 512 * i_, r_ = p_ >> 4, c2_ = p_ & 15; \
                *(LAS v4u*)(lds + (bufo) + SC_QE + r_ * GP + c2_ * 16) = rq##X[i_]; *(LAS v4u*)(lds + (bufo) + SC_KD + r_ * GP + c2_ * 16) = rk##X[i_]; } \
            if (tid < 32) *(LAS v4u*)(lds + (bufo) + SC_DL + tid * 16) = rd##X; } while (0)
#define SC_STEP(c_, bo) do { const int cc = dir ? 127 - (c_) : (c_); \
            _Pragma("unroll") for (int n = 0; n < 4; ++n) *(LAS v2u*)(lds + SC_ST + (16 * n + fr) * GP + (16 * wave + 4 * quad) * 2) = (v2u){cvtpk(S[n][0], S[n][1]), cvtpk(S[n][2], S[n][3])}; \
              \
            const int tt = wave & 3, nb = 2 * (wave >> 2); bf16x8 af[2], qf[4], vf[2][4], kf[2], sf[2][4]; \
            _Pragma("unroll") for (int ks = 0; ks < 2; ++ks) af[ks] = *(const LAS bf16x8*)(lds + (bo) + SC_ATT + (16 * tt + fr) * SC_AP + (32 * ks + 8 * quad) * 2); \
            _Pragma("unroll") for (int ks = 0; ks < 4; ++ks) qf[ks] = *(const LAS bf16x8*)(lds + (bo) + SC_QE + (16 * tt + fr) * GP + (32 * ks + 8 * quad) * 2); \
            _Pragma("unroll") for (int ks = 0; ks < 2; ++ks) { \
                _Pragma("unroll") for (int n = 0; n < 4; ++n) { const LAS unsigned char* vp = lds + (bo) + SC_V + (32 * ks + 8 * quad + (fr >> 2)) * SC_VP + (16 * n + 4 * (fr & 3)) * 2; \
                    const s16x4 lo = tr_read(vp), hi = tr_read(vp + 4 * SC_VP); vf[ks][n] = __builtin_shufflevector(lo, hi, 0, 1, 2, 3, 4, 5, 6, 7); } \
                const LAS unsigned char* kp = lds + (bo) + SC_KD + (32 * ks + 8 * quad + (fr >> 2)) * GP + (16 * wave + 4 * (fr & 3)) * 2; \
                const s16x4 klo = tr_read(kp), khi = tr_read(kp + 4 * GP); kf[ks] = __builtin_shufflevector(klo, khi, 0, 1, 2, 3, 4, 5, 6, 7); } \
            const f32x4 dl = *(const LAS f32x4*)(lds + (bo) + SC_DL + (16 * wave + 4 * quad) * 4); \
            __syncthreads(); \
            _Pragma("unroll") for (int j = 0; j < 2; ++j) _Pragma("unroll") for (int ks = 0; ks < 4; ++ks) sf[j][ks] = *(const LAS bf16x8*)(lds + SC_ST + (16 * (nb + j) + fr) * GP + (32 * ks + 8 * quad) * 2); \
            f32x4 acc0 = {0.f, 0.f, 0.f, 0.f}, acc1 = {0.f, 0.f, 0.f, 0.f}; \
            _Pragma("unroll") for (int ks = 0; ks < 2; ++ks) { acc0 = MFMA16((nb ? vf[ks][2] : vf[ks][0]), af[ks], acc0); acc1 = MFMA16((nb ? vf[ks][3] : vf[ks][1]), af[ks], acc1); } \
            _Pragma("unroll") for (int n = 0; n < 4; ++n) S[n] = S[n] * dl; \
            _Pragma("unroll") for (int ks = 0; ks < 2; ++ks) _Pragma("unroll") for (int n = 0; n < 4; ++n) S[n] = MFMA16(kf[ks], vf[ks][n], S[n]); \
            _Pragma("unroll") for (int ks = 0; ks < 4; ++ks) { acc0 = MFMA16(sf[0][ks], qf[ks], acc0); acc1 = MFMA16(sf[1][ks], qf[ks], acc1); } \
            { const size_t orow = (size_t)b * SEQ + 64 * cc + 16 * tt + fr; bf16* op = OUT + orow * GVC + h * 256 + dvs * 64 + 16 * nb + 4 * quad; \
              *(v2u*)op = (v2u){cvtpk(acc0[0], acc0[1]), cvtpk(acc0[2], acc0[3])}; *(v2u*)(op + 16) = (v2u){cvtpk(acc1[0], acc1[1]), cvtpk(acc1[2], acc1[3])}; } } while (0)
        __syncthreads();
        SC_LOAD(A, 0); SC_STORE(A, 0); SC_LOAD(A, 1);
        __syncthreads();
        for (int c = 0; c < 128; c += 2) {
            SC_LOAD(B, c + 2);
            SC_STEP(c, 0);
            SC_STORE(A, SC_BUF);
            __syncthreads();
            SC_LOAD(A, c + 3);
            SC_STEP(c + 1, SC_BUF);
            SC_STORE(B, 0);
            __syncthreads();
        }
#undef SC_STEP
#undef SC_LOAD
#undef SC_STORE
    }
}
enum Phase { PH_PRO = 0, PH_QKV, PH_ATT, PH_AOUT, PH_UP0, PH_DN0, PH_GIN, PH_GPREP, PH_GSCAN, PH_GNORM, PH_GOUT, PH_UP1, PH_DN1, PH_LN4, PH_COUNT };

__global__ void __launch_bounds__(NTHREADS, 2) fwd_kernel(Args a) {
    extern __shared__ __attribute__((aligned(16))) unsigned char lds_raw[];
    LAS unsigned char* lds = (LAS unsigned char*)lds_raw;
    cg::grid_group grid = cg::this_grid();
    const int tid = threadIdx.x, lane = tid & 63, wave = __builtin_amdgcn_readfirstlane(tid >> 6);
    const int G = gridDim.x, blk = blockIdx.x;
    const int gw = blk * NWAVES + wave, NGW = G * NWAVES;
    unsigned char* ws = a.ws;
    bf16* XB = (bf16*)(ws + WS_XB); float* ST1 = (float*)(ws + WS_ST1); float* ST2 = (float*)(ws + WS_ST2); float* ST3 = (float*)(ws + WS_ST3); float* FOLD = (float*)(ws + WS_FOLD);
    bf16* HB = (bf16*)(ws + WS_R);
    const int lo = a.ph_lo, hi = a.ph_hi;
    if (a.ph_lo < 0) grid.sync();
    if (tid < 32) ((LAS unsigned*)(lds + MISC_OFF))[tid] = 0u;
    __syncthreads();
    XcdBarrier bar = xcd_barrier_post((unsigned*)(ws + WS_CTL) + 1024, (volatile LAS unsigned*)(lds + MISC_OFF) + 8);
#define IN(k) (lo <= (k) && (k) < hi)
#define SEAM(k) do { if (IN(k) && IN((k) + 1)) xcd_barrier(bar); } while (0)
#define GEMM_RUN(EPI, g, S, E) pg8::gemm_phase<EPI, pg8::StaticOrder, PG8_ALIGN, PG8_SP2>(lds, g, S, E)
    if (IN(PH_PRO)) { p0_prologue(a, lds, gw, NGW, wave, lane); } SEAM(PH_PRO);
    if (IN(PH_QKV)) {
        pg8::Gemm g{XB, (const bf16*)(ws + WS_WAIN), M, A_IN, DM}; pg8::StaticOrder S; S.init(M, A_IN, G, blk);
        pg8::EpiQKV E{(bf16*)(ws + WS_Q), (bf16*)(ws + WS_K), (bf16*)(ws + WS_V), (const float*)(ws + WS_COS), (const float*)(ws + WS_SIN), 0.125f * LOG2E};
        GEMM_RUN(pg8::EpiQKV, g, S, E);
    } SEAM(PH_QKV);
    if (IN(PH_ATT)) { attn_mfma((const bf16*)(ws + WS_Q), (const bf16*)(ws + WS_K), (const bf16*)(ws + WS_V), (bf16*)(ws + WS_O), a.in[3], lds, blk, G, tid); } SEAM(PH_ATT);
    if (IN(PH_AOUT)) {
        pg8::Gemm g{(const bf16*)(ws + WS_O), (const bf16*)(ws + WS_WAOUT), M, DM, DM}; pg8::StaticOrder S; S.init(M, DM, G, blk);
        pg8::EpiRes<2> E{nullptr, XB, nullptr, nullptr, nullptr, XB, ST1};
        GEMM_RUN(pg8::EpiRes<2>, g, S, E);
    } SEAM(PH_AOUT);
    if (IN(PH_UP0)) {
        pg8::Gemm g{XB, (const bf16*)(ws + WS_W1), M, FF, DM}; pg8::StaticOrder S; S.init(M, FF, G, blk);
        pg8::EpiSqRelu E{HB, FF, pg8::LnFold{ST1, FOLD, FOLD + 4096}};
        GEMM_RUN(pg8::EpiSqRelu, g, S, E);
    } SEAM(PH_UP0);
    if (IN(PH_DN0)) {
        pg8::Gemm g{HB, (const bf16*)(ws + WS_W2), M, DM, FF}; pg8::StaticOrder S; S.init(M, DM, G, blk);
        pg8::EpiRes<1> E{nullptr, XB, ST1, a.in[12], a.in[13], XB, ST2};
        GEMM_RUN(pg8::EpiRes<1>, g, S, E);
    } SEAM(PH_DN0);
    if (IN(PH_GIN)) {
        pg8::Gemm g{XB, (const bf16*)(ws + WS_WGIN), M, G_INP, DM}; pg8::StaticOrder S; S.init(M, G_INP, G, blk);
        pg8::EpiGin E{(bf16*)(ws + WS_GQ), (bf16*)(ws + WS_GK), (bf16*)(ws + WS_GV), (bf16*)(ws + WS_GR), (float*)(ws + WS_LR), 0.08838834764831845f, pg8::LnFold{ST2, FOLD + 8192, FOLD + 12288}};
        GEMM_RUN(pg8::EpiGin, g, S, E);
    } SEAM(PH_GIN);
    if (IN(PH_GPREP)) {
        gla_prep((bf16*)(ws + WS_GQ), (bf16*)(ws + WS_GK), (bf16*)(ws + WS_QEB), (bf16*)(ws + WS_KDB), (const float*)(ws + WS_LR), a.in[6], a.in[7], a.in[8], a.in[9],
                 (float*)(ws + WS_DL), (bf16*)(ws + WS_ATT), lds, blk, G, tid);
    } SEAM(PH_GPREP);
    if (IN(PH_GSCAN)) {
        gla_scan((const bf16*)(ws + WS_GQ), (const bf16*)(ws + WS_QEB), (const bf16*)(ws + WS_GK), (const bf16*)(ws + WS_KDB), (const bf16*)(ws + WS_GV), (const float*)(ws + WS_DL), (const bf16*)(ws + WS_ATT),
                 (bf16*)a.out, (bf16*)a.out + (size_t)M * GVC, lds, blk, G, tid);
    } SEAM(PH_GSCAN);
    if (IN(PH_GNORM)) { gla_norm_pass((const bf16*)a.out, (const bf16*)a.out + (size_t)M * GVC, (const bf16*)(ws + WS_GR), a.in[10], (bf16*)a.out, gw, NGW, lane); } SEAM(PH_GNORM);
    if (IN(PH_GOUT)) {
        pg8::Gemm g{(const bf16*)a.out, (const bf16*)(ws + WS_WGOUT), M, DM, DM}; pg8::StaticOrder S; S.init(M, DM, G, blk);
        pg8::EpiRes<1> E{nullptr, XB, ST2, a.in[16], a.in[17], XB, ST3};
        GEMM_RUN(pg8::EpiRes<1>, g, S, E);
    } SEAM(PH_GOUT);
    if (IN(PH_UP1)) {
        pg8::Gemm g{XB, (const bf16*)(ws + WS_W1 + 8 * MiB), M, FF, DM}; pg8::StaticOrder S; S.init(M, FF, G, blk);
        pg8::EpiSqRelu E{HB, FF, pg8::LnFold{ST3, FOLD + 16384, FOLD + 20480}};
        GEMM_RUN(pg8::EpiSqRelu, g, S, E);
    } SEAM(PH_UP1);
    if (IN(PH_DN1)) {
        pg8::Gemm g{HB, (const bf16*)(ws + WS_W2 + 8 * MiB), M, DM, FF}; pg8::StaticOrder S; S.init(M, DM, G, blk);
        pg8::EpiRes<1> E{nullptr, XB, ST3, a.in[12] + DM, a.in[13] + DM, XB, (float*)(ws + WS_ST4)};
        GEMM_RUN(pg8::EpiRes<1>, g, S, E);
    } SEAM(PH_DN1);
    if (IN(PH_LN4)) { ln_final_pass(XB, (const float*)(ws + WS_ST4), a.in[16] + DM, a.in[17] + DM, a.out, gw, NGW, lane); }
#undef IN
#undef SEAM
#undef GEMM_RUN
}

#ifndef MK_MULTI
#define MK_MULTI 0
#endif
extern "C" void kernel_launch(void* const* d_in, const int* in_sizes, int n_in, void* d_out, int out_size, void* d_ws, size_t ws_size, hipStream_t stream) {
    static int grid = 0;
    if (grid == 0) {
        if (n_in != 18 || in_sizes[0] != M * DM || out_size != M * DM || ws_size < WS_END) { fprintf(stderr, "kernel_launch: unexpected shapes (n_in %d, in0 %d, out %d, ws %zu); nothing launched\n", n_in, n_in > 0 ? in_sizes[0] : -1, out_size, ws_size); grid = -1; return; }
        int dev = 0, cus = 0, per_cu = 0;
        hipGetDevice(&dev); hipDeviceGetAttribute(&cus, hipDeviceAttributeMultiprocessorCount, dev);
        if (hipFuncSetAttribute((const void*)fwd_kernel, hipFuncAttributeMaxDynamicSharedMemorySize, LDS_BYTES) != hipSuccess) { fprintf(stderr, "kernel_launch: hipFuncSetAttribute failed\n"); grid = -1; return; }
        hipOccupancyMaxActiveBlocksPerMultiprocessor(&per_cu, (const void*)fwd_kernel, NTHREADS, LDS_BYTES);
        if (per_cu < 1) { fprintf(stderr, "kernel_launch: occupancy query says %d blocks per CU\n", per_cu); per_cu = 1; }
        (void)hipGetLastError();
        grid = cus * 1;
        fprintf(stderr, "kernel_launch: cus %d per_cu %d grid %d\n", cus, per_cu, grid);
    }
    if (grid < 0) return;
    if (hipMemsetAsync((char*)d_ws + WS_CTL, 0, CTL_ZERO_BYTES, stream) != hipSuccess) { fprintf(stderr, "kernel_launch: memset failed\n"); return; }
    Args a{};
    for (int i = 0; i < 18; ++i) a.in[i] = (const float*)d_in[i];
    a.out = (float*)d_out; a.ws = (unsigned char*)d_ws;
#if MK_MULTI
    for (int ph = 0; ph < PH_COUNT; ++ph) { a.ph_lo = ph; a.ph_hi = ph + 1; hipLaunchKernelGGL(fwd_kernel, dim3(grid), dim3(NTHREADS), LDS_BYTES, stream, a); }
#else
    a.ph_lo = 0; a.ph_hi = PH_COUNT;
    void* args[] = {&a};
    hipError_t e = hipLaunchCooperativeKernel((const void*)fwd_kernel, dim3(grid), dim3(NTHREADS), args, LDS_BYTES, stream);
    if (e != hipSuccess) fprintf(stderr, "cooperative launch failed: %s (grid %d)\n", hipGetErrorString(e), grid);
#endif
}
```
